# Optimizing an MI355X kernel written in HIP

```python
import math
import jax, jax.numpy as jnp
from jax import lax
import numpy as np

D_MODEL = 1024
BATCH = 8
SEQ = 4096
DEPTH = 2

N_A_LAYERS = DEPTH // 2
N_B_LAYERS = DEPTH - N_A_LAYERS

MLA_HEADS = 8
MLA_NOPE = 128
MLA_ROPE = 64
MLA_V = 128
MLA_Q_LORA = 384
MLA_KV_LORA = 256

DIFF_HEADS = 8
DIFF_HEAD_DIM = 64
DIFF_QK_WIDTH = DIFF_HEADS * 2 * DIFF_HEAD_DIM
DIFF_V_WIDTH = DIFF_HEADS * 2 * DIFF_HEAD_DIM

D_FF = -(-8 * D_MODEL // (3 * 256)) * 256

ROPE_THETA = 10000.0
Q_BLOCK = 128
DEEPNORM_ALPHA = (2.0 * DEPTH) ** 0.25
DEEPNORM_BETA = (8.0 * DEPTH) ** -0.25
LN_EPS = 1e-5
RMS_EPS = 1e-6

kernel_name = "yoco_mla_diffattn_deepnorm"

F32 = jnp.float32


def _layernorm(x, g, b):
    xf = x.astype(F32)
    mu = jnp.mean(xf, axis=-1, keepdims=True)
    var = jnp.mean(jnp.square(xf - mu), axis=-1, keepdims=True)
    y = (xf - mu) * lax.rsqrt(var + LN_EPS)
    return (y * g.astype(F32) + b.astype(F32)).astype(x.dtype)


def _rmsnorm(x, g):
    xf = x.astype(F32)
    y = xf * lax.rsqrt(jnp.mean(jnp.square(xf), axis=-1, keepdims=True) + RMS_EPS)
    return (y * g.astype(F32)).astype(x.dtype)


def _rope_tables(seq_len, dim):
    inv = 1.0 / (ROPE_THETA ** (jnp.arange(0, dim, 2, dtype=F32) / dim))
    ang = jnp.arange(seq_len, dtype=F32)[:, None] * inv[None, :]
    ang = jnp.concatenate([ang, ang], axis=-1)
    return jnp.cos(ang), jnp.sin(ang)


def _rope(x, cos, sin):
    shape = (1, x.shape[1]) + (1,) * (x.ndim - 3) + (x.shape[-1],)
    c = cos.reshape(shape)
    s = sin.reshape(shape)
    xf = x.astype(F32)
    half = x.shape[-1] // 2
    rot = jnp.concatenate([-xf[..., half:], xf[..., :half]], axis=-1)
    return (xf * c + rot * s).astype(x.dtype)


def _causal_mask(i, seq_len):
    qpos = i * Q_BLOCK + jnp.arange(Q_BLOCK)
    kpos = jnp.arange(seq_len)
    return kpos[None, :] <= qpos[:, None]


def _sweep_query_blocks(block_fn, seq_len):
    out = lax.map(block_fn, jnp.arange(seq_len // Q_BLOCK))
    out = jnp.moveaxis(out, 0, 1)
    return out.reshape((out.shape[0], seq_len) + out.shape[3:])


def _mla(h, w_dq, q_norm, w_uq, w_dkv, kv_norm, w_ukv, w_o, cos, sin):
    B, S, _ = h.shape
    cq = _rmsnorm(h @ w_dq, q_norm)
    q = (cq @ w_uq).reshape(B, S, MLA_HEADS, MLA_NOPE + MLA_ROPE)
    q_nope = q[..., :MLA_NOPE]
    q_rope = _rope(q[..., MLA_NOPE:], cos, sin)
    ckv = h @ w_dkv
    c = _rmsnorm(ckv[..., :MLA_KV_LORA], kv_norm)
    k_rope = _rope(ckv[..., MLA_KV_LORA:], cos, sin)
    kv = (c @ w_ukv).reshape(B, S, MLA_HEADS, MLA_NOPE + MLA_V)
    k_nope = kv[..., :MLA_NOPE]
    v = kv[..., MLA_NOPE:]
    scale = (MLA_NOPE + MLA_ROPE) ** -0.5

    def block(i):
        start = i * Q_BLOCK
        qn = lax.dynamic_slice_in_dim(q_nope, start, Q_BLOCK, axis=1)
        qr = lax.dynamic_slice_in_dim(q_rope, start, Q_BLOCK, axis=1)
        s = (jnp.einsum('bqhd,bkhd->bhqk', qn, k_nope).astype(F32)
             + jnp.einsum('bqhr,bkr->bhqk', qr, k_rope).astype(F32)) * scale
        s = jnp.where(_causal_mask(i, S)[None, None], s, -jnp.inf)
        p = jax.nn.softmax(s, axis=-1).astype(v.dtype)
        return jnp.einsum('bhqk,bkhd->bqhd', p, v)

    o = _sweep_query_blocks(block, S)
    return o.reshape(B, S, MLA_HEADS * MLA_V) @ w_o


def _shared_kv(h, w_kv, cos, sin):
    B, S, _ = h.shape
    kv = h @ w_kv
    k = _rope(kv[..., :DIFF_QK_WIDTH].reshape(B, S, DIFF_HEADS, 2, DIFF_HEAD_DIM), cos, sin)
    v = kv[..., DIFF_QK_WIDTH:].reshape(B, S, DIFF_HEADS, 2 * DIFF_HEAD_DIM)
    return k, v


def _diff_attn(h, k, v, w_q, lq1, lk1, lq2, lk2, subln, w_o, lambda_init, cos, sin):
    B, S, _ = h.shape
    q = _rope((h @ w_q).reshape(B, S, DIFF_HEADS, 2, DIFF_HEAD_DIM), cos, sin)
    lam = (jnp.exp(jnp.sum(lq1.astype(F32) * lk1.astype(F32)))
           - jnp.exp(jnp.sum(lq2.astype(F32) * lk2.astype(F32))) + lambda_init)
    scale = DIFF_HEAD_DIM ** -0.5

    def block(i):
        qb = lax.dynamic_slice_in_dim(q, i * Q_BLOCK, Q_BLOCK, axis=1)
        s = jnp.einsum('bqhcd,bkhcd->bhcqk', qb, k).astype(F32) * scale
        s = jnp.where(_causal_mask(i, S)[None, None, None], s, -jnp.inf)
        p = jax.nn.softmax(s, axis=-1)
        w = (p[:, :, 0] - lam * p[:, :, 1]).astype(v.dtype)
        return jnp.einsum('bhqk,bkhe->bqhe', w, v)

    o = _sweep_query_blocks(block, S)
    o = _rmsnorm(o, subln) * (1.0 - lambda_init)
    return o.reshape(B, S, DIFF_V_WIDTH) @ w_o


def _swiglu(h, w_gate_up, w_down):
    gu = h @ w_gate_up
    g, u = gu[..., :D_FF], gu[..., D_FF:]
    return (jax.nn.silu(g) * u) @ w_down


def _w(k, shape, fan_in, scale=1.0):
    return jax.random.normal(k, shape, F32) * (scale * fan_in ** -0.5)


def setup_inputs(seed: int = 0) -> dict:
    key = jax.random.key(seed)
    ks = iter(jax.random.split(key, 32))
    nA, nB, L = N_A_LAYERS, N_B_LAYERS, DEPTH
    x = jax.random.normal(next(ks), (BATCH, SEQ, D_MODEL), F32)

    mla_w_dq = _w(next(ks), (nA, D_MODEL, MLA_Q_LORA), D_MODEL)
    mla_q_norm = 1.0 + 0.02 * jax.random.normal(next(ks), (nA, MLA_Q_LORA), F32)
    mla_w_uq = _w(next(ks), (nA, MLA_Q_LORA, MLA_HEADS * (MLA_NOPE + MLA_ROPE)), MLA_Q_LORA)
    mla_w_dkv = _w(next(ks), (nA, D_MODEL, MLA_KV_LORA + MLA_ROPE), D_MODEL)
    mla_kv_norm = 1.0 + 0.02 * jax.random.normal(next(ks), (nA, MLA_KV_LORA), F32)
    uk = _w(next(ks), (nA, MLA_KV_LORA, MLA_HEADS, MLA_NOPE), MLA_KV_LORA)
    uv = _w(next(ks), (nA, MLA_KV_LORA, MLA_HEADS, MLA_V), MLA_KV_LORA, DEEPNORM_BETA)
    mla_w_ukv = jnp.concatenate([uk, uv], axis=-1).reshape(nA, MLA_KV_LORA, MLA_HEADS * (MLA_NOPE + MLA_V))
    mla_w_o = _w(next(ks), (nA, MLA_HEADS * MLA_V, D_MODEL), MLA_HEADS * MLA_V, DEEPNORM_BETA)

    wk = _w(next(ks), (D_MODEL, DIFF_QK_WIDTH), D_MODEL)
    wv = _w(next(ks), (D_MODEL, DIFF_V_WIDTH), D_MODEL, DEEPNORM_BETA)
    kv_w = jnp.concatenate([wk, wv], axis=-1)

    diff_w_q = _w(next(ks), (nB, D_MODEL, DIFF_QK_WIDTH), D_MODEL)
    diff_lq1 = 0.1 * jax.random.normal(next(ks), (nB, DIFF_HEAD_DIM), F32)
    diff_lk1 = 0.1 * jax.random.normal(next(ks), (nB, DIFF_HEAD_DIM), F32)
    diff_lq2 = 0.1 * jax.random.normal(next(ks), (nB, DIFF_HEAD_DIM), F32)
    diff_lk2 = 0.1 * jax.random.normal(next(ks), (nB, DIFF_HEAD_DIM), F32)
    diff_subln = 1.0 + 0.02 * jax.random.normal(next(ks), (nB, 2 * DIFF_HEAD_DIM), F32)
    diff_w_o = _w(next(ks), (nB, DIFF_V_WIDTH, D_MODEL), DIFF_V_WIDTH, DEEPNORM_BETA)

    ln1_g = 1.0 + 0.02 * jax.random.normal(next(ks), (L, D_MODEL), F32)
    ln1_b = 0.02 * jax.random.normal(next(ks), (L, D_MODEL), F32)
    ln2_g = 1.0 + 0.02 * jax.random.normal(next(ks), (L, D_MODEL), F32)
    ln2_b = 0.02 * jax.random.normal(next(ks), (L, D_MODEL), F32)
    ffn_w_gate_up = _w(next(ks), (L, D_MODEL, 2 * D_FF), D_MODEL)
    ffn_w_down = _w(next(ks), (L, D_FF, D_MODEL), D_FF, DEEPNORM_BETA)

    return {"x": x,
            "mla_w_dq": mla_w_dq, "mla_q_norm": mla_q_norm, "mla_w_uq": mla_w_uq,
            "mla_w_dkv": mla_w_dkv, "mla_kv_norm": mla_kv_norm, "mla_w_ukv": mla_w_ukv,
            "mla_w_o": mla_w_o,
            "kv_w": kv_w,
            "diff_w_q": diff_w_q, "diff_lq1": diff_lq1, "diff_lk1": diff_lk1,
            "diff_lq2": diff_lq2, "diff_lk2": diff_lk2, "diff_subln": diff_subln,
            "diff_w_o": diff_w_o,
            "ln1_g": ln1_g, "ln1_b": ln1_b, "ln2_g": ln2_g, "ln2_b": ln2_b,
            "ffn_w_gate_up": ffn_w_gate_up, "ffn_w_down": ffn_w_down}


def reference(x, mla_w_dq, mla_q_norm, mla_w_uq, mla_w_dkv, mla_kv_norm, mla_w_ukv, mla_w_o,
              kv_w, diff_w_q, diff_lq1, diff_lk1, diff_lq2, diff_lk2, diff_subln, diff_w_o,
              ln1_g, ln1_b, ln2_g, ln2_b, ffn_w_gate_up, ffn_w_down):
    S = x.shape[1]
    cos_m, sin_m = _rope_tables(S, MLA_ROPE)
    cos_d, sin_d = _rope_tables(S, DIFF_HEAD_DIM)
    h = x
    k_sh = v_sh = None
    for l in range(DEPTH):
        if l < N_A_LAYERS:
            a = _mla(h, mla_w_dq[l], mla_q_norm[l], mla_w_uq[l], mla_w_dkv[l], mla_kv_norm[l],
                     mla_w_ukv[l], mla_w_o[l], cos_m, sin_m)
        else:
            if l == N_A_LAYERS:
                k_sh, v_sh = _shared_kv(h, kv_w, cos_d, sin_d)
            j = l - N_A_LAYERS
            lambda_init = 0.8 - 0.6 * math.exp(-0.3 * l)
            a = _diff_attn(h, k_sh, v_sh, diff_w_q[j], diff_lq1[j], diff_lk1[j], diff_lq2[j],
                           diff_lk2[j], diff_subln[j], diff_w_o[j], lambda_init, cos_d, sin_d)
        h = _layernorm(DEEPNORM_ALPHA * h + a, ln1_g[l], ln1_b[l])
        h = _layernorm(DEEPNORM_ALPHA * h + _swiglu(h, ffn_w_gate_up[l], ffn_w_down[l]), ln2_g[l], ln2_b[l])
    return h
```

```cpp
#include <hip/hip_runtime.h>
#include <hip/hip_cooperative_groups.h>
#include <cstdio>
#include <cstdint>
namespace cg = cooperative_groups;
namespace pg8 {
#define PG8_LAS __attribute__((address_space(3)))
typedef unsigned short bf16_t;
typedef short bf16x8 __attribute__((ext_vector_type(8)));
typedef float f32x4 __attribute__((ext_vector_type(4)));
typedef unsigned u32x4 __attribute__((ext_vector_type(4)));
constexpr int BM = 256, BK = 64, HALF = 128, HTB = HALF * BK * 2  , STAGE_BYTES = 8 * HTB, NXCD = 8, WGM = 8;

__host__ __device__ __forceinline__ int lds_byte(int r, int c) { const int st = (r >> 4) * 2 + (c >> 5), rr = r & 15, cc = c & 31, ob = rr * 64 + cc * 2; return st * 1024 + (ob ^ (((ob >> 9) & 1) << 5)); }
__host__ __device__ __forceinline__ void stage_rc(int b, int& R, int& C) { const int st = b / 1024, sb = b % 1024, swz = sb ^ (((sb >> 9) & 1) << 5); R = (st >> 1) * 16 + swz / 64; C = (st & 1) * 32 + (swz % 64) / 2; }
__host__ __device__ __forceinline__ int perm32(int rho) { const int n = rho >> 4, i = rho & 15; return 8 * (i >> 2) + 4 * n + (i & 3); }

struct Unit { int pm, pn; };
struct Gemm { const bf16_t* A; const bf16_t* Bt; int M, N, K; };

struct StaticOrder {
    int nM, nN, nwg, G, c;
    __host__ __device__ void init(int M, int N, int G_, int c_) { nM = M / BM; nN = N / BM; nwg = nM * nN; G = G_; c = c_; }
    __host__ __device__ bool next(int i, Unit& u) const {
        const long L = (long)i * G + c; if (L >= nwg) return false;
        int wgid = (int)L; { const int q = nwg / NXCD, r = nwg % NXCD, xcd = wgid % NXCD, off = wgid / NXCD; wgid = (xcd < r ? xcd * (q + 1) : r * (q + 1) + (xcd - r) * q) + off; }
        const int nig = WGM * nN, gid = wgid / nig, fm = gid * WGM, gsz = (nM - fm) < WGM ? (nM - fm) : WGM;
        u.pm = fm + ((wgid % nig) % gsz); u.pn = (wgid % nig) / gsz; return true;
    }
    __device__ __forceinline__ void a_ready(const Unit&) const {}
    __device__ __forceinline__ void done(const Unit&) const {}
};
__device__ __forceinline__ unsigned cvt_pk_bf16(float lo, float hi) { unsigned r; asm volatile("v_cvt_pk_bf16_f32 %0, %1, %2" : "=v"(r) : "v"(lo), "v"(hi)); return r; }
typedef float f32x2 __attribute__((ext_vector_type(2)));
__device__ __forceinline__ u32x4 pack8(f32x4 a, f32x4 b) { u32x4 w; w.x = cvt_pk_bf16(a[0], a[1]); w.y = cvt_pk_bf16(a[2], a[3]); w.z = cvt_pk_bf16(b[0], b[1]); w.w = cvt_pk_bf16(b[2], b[3]); return w; }

struct EpiF32 {
    static constexpr bool PERM = false, AFTER_DRAIN = false;
    float* out; const float* res; int ldc; float alpha;
    __device__ __forceinline__ void operator()(const f32x4 (&acc)[2][2][4][2], const Unit& u, int wr, int wc, int fr, int fq) const {
        const int row0 = u.pm * BM + wr * 64 + fr, col0 = u.pn * BM + wc * 32 + 4 * fq;
#pragma unroll
        for (int ai = 0; ai < 2; ++ai)
#pragma unroll
            for (int m = 0; m < 4; ++m) { const size_t off = (size_t)(row0 + ai * HALF + m * 16) * ldc + col0;
#pragma unroll
                for (int bj = 0; bj < 2; ++bj)
#pragma unroll
                    for (int n = 0; n < 2; ++n) { f32x4 v = acc[ai][bj][m][n];
                        if (res) { const f32x4 r = *(const f32x4*)(res + off + bj * HALF + n * 16); v = v + r * alpha; }
                        *(f32x4*)(out + off + bj * HALF + n * 16) = v; } }
    }
};

struct EpiPair {
    static constexpr bool PERM = true, AFTER_DRAIN = false;
    int mode; bf16_t* D0; bf16_t* D1; const float* cosT; const float* sinT;
    __device__ __forceinline__ void operator()(const f32x4 (&acc)[2][2][4][2], const Unit& u, int wr, int wc, int fr, int fq) const {
        const int g = 4 * u.pn + wc; bf16_t* base; int pitch, col; bool rope;
        if (mode == 0) { base = D0; pitch = 1536; col = 64 * g; rope = (g % 3) == 2; }
        else if (mode == 1) { if (wc < 2) { base = D0; pitch = 1536; col = u.pn * 192 + 64 * wc; } else { base = D1; pitch = 1024; col = u.pn * 128 + 64 * (wc - 2); } rope = false; }
        else { base = D0; pitch = 3072; col = 64 * g; rope = (u.pn < 4) || (u.pn >= 8); }
        const int row0 = u.pm * BM + wr * 64 + fr;
#pragma unroll
        for (int ai = 0; ai < 2; ++ai)
#pragma unroll
            for (int m = 0; m < 4; ++m) { const int row = row0 + ai * HALF + m * 16;
                f32x4 v00 = acc[ai][0][m][0], v01 = acc[ai][0][m][1], v10 = acc[ai][1][m][0], v11 = acc[ai][1][m][1];
                if (rope) { const int pos = row & 4095; const float* cp = cosT + pos * 32 + 8 * fq; const float* sp = sinT + pos * 32 + 8 * fq;
                    const f32x4 c0 = *(const f32x4*)cp, c1 = *(const f32x4*)(cp + 4), s0 = *(const f32x4*)sp, s1 = *(const f32x4*)(sp + 4);
                    const f32x4 a0 = v00 * c0 - v10 * s0, a1 = v01 * c1 - v11 * s1, b0 = v10 * c0 + v00 * s0, b1 = v11 * c1 + v01 * s1;
                    v00 = a0; v01 = a1; v10 = b0; v11 = b1; }
                bf16_t* rp = base + (size_t)row * pitch + col + 8 * fq;
                *(u32x4*)rp = pack8(v00, v01); *(u32x4*)(rp + 32) = pack8(v10, v11); }
    }
};

struct EpiSwiglu {
    static constexpr bool PERM = true, AFTER_DRAIN = false;
    bf16_t* O; int ldc;
    __device__ __forceinline__ static f32x4 act(f32x4 g, f32x4 u) { f32x4 r;
#pragma unroll
        for (int j = 0; j < 4; ++j) { const float e = __builtin_amdgcn_exp2f(g[j] * -1.4426950408889634f); r[j] = g[j] * __builtin_amdgcn_rcpf(1.0f + e) * u[j]; }
        return r; }
    __device__ __forceinline__ void operator()(const f32x4 (&acc)[2][2][4][2], const Unit& u, int wr, int wc, int fr, int fq) const {
        const int row0 = u.pm * BM + wr * 64 + fr, col0 = u.pn * HALF + wc * 32 + 8 * fq;
#pragma unroll
        for (int ai = 0; ai < 2; ++ai)
#pragma unroll
            for (int m = 0; m < 4; ++m) { bf16_t* rp = O + (size_t)(row0 + ai * HALF + m * 16) * ldc + col0;
                *(u32x4*)rp = pack8(act(acc[ai][0][m][0], acc[ai][1][m][0]), act(acc[ai][0][m][1], acc[ai][1][m][1])); }
    }
};

template <class Epi, class Sched, bool ALIGN_EPI = false, bool SP2 = false>
__device__ __forceinline__ void gemm_phase(PG8_LAS unsigned char* lds, const Gemm g, const Sched& S, const Epi& E) {
    int tid_ = threadIdx.x; asm volatile("" : "+v"(tid_));
    const int tid = tid_, wid = __builtin_amdgcn_readfirstlane(tid >> 6), lane = tid & 63, wr = wid >> 2, wc = wid & 3, fr = lane & 15, fq = lane >> 4;
    const int K = g.K, nt = K / BK;
    unsigned voffA[2], voffB[2];
#pragma unroll
    for (int i = 0; i < 2; ++i) { int R, C; stage_rc(tid * 16 + i * 8192, R, C); const int Rb = Epi::PERM ? ((R & ~31) + perm32(R & 31)) : R;
        voffA[i] = (unsigned)(R * K + C) * 2u; voffB[i] = (unsigned)(Rb * K + C) * 2u; }
    const size_t kstep = (size_t)(BK * 2);
    const size_t hstep = (size_t)HALF * K * 2;
    const size_t tstep = 2 * hstep;
    const unsigned ldsw = (unsigned)wid * 1024u;
    const int aoff = lds_byte(wr * 64 + fr, fq * 8), boff = lds_byte(wc * 32 + fr, fq * 8);
#define PG8_SA(b, h) (((b) * 2 + (h)) * HTB)
#define PG8_SB(b, h) ((4 + (b) * 2 + (h)) * HTB)
#define PG8_STAGE(bufoff, gbase, voff) do { _Pragma("unroll") for (int _i = 0; _i < 2; ++_i) \
        __builtin_amdgcn_global_load_lds((const unsigned*)((const char*)(gbase) + (voff)[_i]), (PG8_LAS unsigned*)(lds + (bufoff) + ldsw + _i * 8192), 16, 0, 0); } while (0)
#define PG8_LDA(dst, b, h) do { _Pragma("unroll") for (int m = 0; m < 4; ++m) _Pragma("unroll") for (int k = 0; k < 2; ++k) dst[m][k] = *(const PG8_LAS bf16x8*)(lds + PG8_SA(b, h) + aoff + m * 2048 + k * 1024); } while (0)
#define PG8_LDB(dst, b, h) do { _Pragma("unroll") for (int n = 0; n < 2; ++n) _Pragma("unroll") for (int k = 0; k < 2; ++k) dst[n][k] = *(const PG8_LAS bf16x8*)(lds + PG8_SB(b, h) + boff + n * 2048 + k * 1024); } while (0)
#define PG8_MMA(ai, bj, At, Bt) do { __builtin_amdgcn_s_setprio(1); _Pragma("unroll") for (int m = 0; m < 4; ++m) _Pragma("unroll") for (int n = 0; n < 2; ++n) _Pragma("unroll") for (int k = 0; k < 2; ++k) \
        acc[ai][bj][m][n] = __builtin_amdgcn_mfma_f32_16x16x32_bf16(Bt[n][k], At[m][k], acc[ai][bj][m][n], 0, 0, 0); __builtin_amdgcn_s_setprio(0); } while (0)
#define PG8_WAIT_V(n) asm volatile("s_waitcnt vmcnt(" #n ")" ::: "memory")
#define PG8_WAIT_L(n) asm volatile("s_waitcnt lgkmcnt(" #n ")" ::: "memory")
#define PG8_BAR __builtin_amdgcn_s_barrier()
#define PG8_SCHED __builtin_amdgcn_sched_barrier(0)
    Unit cur, nxt; int ui = 0;
    if (!S.next(0, cur)) return;
    f32x4 acc[2][2][4][2];
#pragma unroll
    for (int a = 0; a < 2; ++a)
#pragma unroll
        for (int b = 0; b < 2; ++b)
#pragma unroll
            for (int m = 0; m < 4; ++m)
#pragma unroll
                for (int n = 0; n < 2; ++n) acc[a][b][m][n] = (f32x4){0.f, 0.f, 0.f, 0.f};
    bf16x8 At[4][2], B0[2][2], B1[2][2];
    const char* cA = (const char*)g.A + (size_t)cur.pm * tstep; const char* cB = (const char*)g.Bt + (size_t)cur.pn * tstep;
    S.a_ready(cur);
    if constexpr (SP2) {
        PG8_STAGE(PG8_SB(0, 0), cB, voffB); PG8_STAGE(PG8_SB(0, 1), cB + hstep, voffB); PG8_STAGE(PG8_SA(0, 0), cA, voffA); PG8_STAGE(PG8_SA(0, 1), cA + hstep, voffA);
        if (wr == 1) PG8_BAR;
        PG8_WAIT_V(2); PG8_BAR;
        PG8_STAGE(PG8_SB(1, 0), cB + kstep, voffB); PG8_STAGE(PG8_SA(1, 0), cA + kstep, voffA); PG8_STAGE(PG8_SB(1, 1), cB + hstep + kstep, voffB);
        PG8_WAIT_V(6); PG8_BAR;
    } else {
        PG8_STAGE(PG8_SB(0, 0), cB, voffB); PG8_STAGE(PG8_SA(0, 0), cA, voffA); PG8_STAGE(PG8_SB(0, 1), cB + hstep, voffB); PG8_STAGE(PG8_SA(0, 1), cA + hstep, voffA);
        if (wr == 1) PG8_BAR;
        PG8_WAIT_V(4); PG8_BAR;
        PG8_STAGE(PG8_SB(1, 0), cB + kstep, voffB); PG8_STAGE(PG8_SA(1, 0), cA + kstep, voffA); PG8_STAGE(PG8_SB(1, 1), cB + hstep + kstep, voffB);
        PG8_WAIT_V(6); PG8_BAR;
    }
    for (;;) {
        const bool has_next = S.next(ui + 1, nxt);
        const char* nA = has_next ? (const char*)g.A + (size_t)nxt.pm * tstep : cA; const char* nB = has_next ? (const char*)g.Bt + (size_t)nxt.pn * tstep : cB;
        for (int t = 0; t < nt; t += 2) {
            const bool last = (t == nt - 2);
            const char* a1 = cA + (size_t)(t + 1) * kstep;
            const char* a2 = last ? nA : cA + (size_t)(t + 2) * kstep; const char* b2 = last ? nB : cB + (size_t)(t + 2) * kstep;
            const char* a3 = a2 + kstep; const char* b3 = b2 + kstep;
            if (last && has_next) S.a_ready(nxt);
            if constexpr (SP2) {
            PG8_LDB(B0, 0, 0); PG8_LDB(B1, 0, 1); PG8_SCHED; PG8_LDA(At, 0, 0); PG8_STAGE(PG8_SA(1, 1), a1 + hstep, voffA);
            PG8_WAIT_V(8); PG8_WAIT_L(0); PG8_BAR; PG8_MMA(0, 0, At, B0); PG8_MMA(0, 1, At, B1); PG8_BAR; PG8_SCHED;
            PG8_LDA(At, 0, 1); PG8_STAGE(PG8_SB(0, 0), b2, voffB); PG8_STAGE(PG8_SB(0, 1), b2 + hstep, voffB); PG8_STAGE(PG8_SA(0, 0), a2, voffA);
            PG8_WAIT_V(8); PG8_WAIT_L(0); PG8_BAR; PG8_MMA(1, 0, At, B0); PG8_MMA(1, 1, At, B1); PG8_BAR; PG8_SCHED;
            PG8_LDB(B0, 1, 0); PG8_LDB(B1, 1, 1); PG8_SCHED; PG8_LDA(At, 1, 0); PG8_STAGE(PG8_SA(0, 1), a2 + hstep, voffA);
            PG8_WAIT_V(8); PG8_WAIT_L(0); PG8_BAR; PG8_MMA(0, 0, At, B0); PG8_MMA(0, 1, At, B1); PG8_BAR; PG8_SCHED;
            PG8_LDA(At, 1, 1); PG8_STAGE(PG8_SB(1, 0), b3, voffB); PG8_STAGE(PG8_SB(1, 1), b3 + hstep, voffB); PG8_STAGE(PG8_SA(1, 0), a3, voffA);
            PG8_WAIT_V(8); PG8_WAIT_L(0); PG8_BAR; PG8_MMA(1, 0, At, B0); PG8_MMA(1, 1, At, B1); PG8_BAR; PG8_SCHED;
            } else {
            PG8_LDB(B0, 0, 0); PG8_SCHED; PG8_LDA(At, 0, 0); PG8_STAGE(PG8_SA(1, 1), a1 + hstep, voffA);
            PG8_WAIT_L(8); PG8_BAR; PG8_WAIT_L(0); PG8_MMA(0, 0, At, B0); PG8_BAR; PG8_SCHED;
            PG8_LDB(B1, 0, 1); PG8_STAGE(PG8_SB(0, 0), b2, voffB);
            PG8_BAR; PG8_WAIT_L(0); PG8_MMA(0, 1, At, B1); PG8_BAR;
            PG8_LDA(At, 0, 1); PG8_STAGE(PG8_SA(0, 0), a2, voffA);
            PG8_BAR; PG8_WAIT_L(0); PG8_MMA(1, 0, At, B0); PG8_BAR; PG8_SCHED;
            PG8_STAGE(PG8_SB(0, 1), b2 + hstep, voffB);
            PG8_WAIT_V(6); PG8_BAR; PG8_MMA(1, 1, At, B1); PG8_BAR;
            PG8_LDB(B0, 1, 0); PG8_SCHED; PG8_LDA(At, 1, 0); PG8_STAGE(PG8_SA(0, 1), a2 + hstep, voffA);
            PG8_WAIT_L(8); PG8_BAR; PG8_WAIT_L(0); PG8_MMA(0, 0, At, B0); PG8_BAR; PG8_SCHED;
            PG8_LDB(B1, 1, 1); PG8_STAGE(PG8_SB(1, 0), b3, voffB);
            PG8_BAR; PG8_WAIT_L(0); PG8_MMA(0, 1, At, B1); PG8_BAR;
            PG8_LDA(At, 1, 1); PG8_STAGE(PG8_SA(1, 0), a3, voffA);
            PG8_BAR; PG8_WAIT_L(0); PG8_MMA(1, 0, At, B0); PG8_BAR; PG8_SCHED;
            PG8_STAGE(PG8_SB(1, 1), b3 + hstep, voffB);
            PG8_WAIT_V(6); PG8_BAR; PG8_MMA(1, 1, At, B1); PG8_BAR;
            }
        }
        if constexpr (ALIGN_EPI) { if (wr == 0) PG8_BAR; }
        if constexpr (!Epi::AFTER_DRAIN) { E(acc, cur, wr, wc, fr, fq); S.done(cur); }
        if (!has_next) break;
#pragma unroll
        for (int a = 0; a < 2; ++a)
#pragma unroll
            for (int b = 0; b < 2; ++b)
#pragma unroll
                for (int m = 0; m < 4; ++m)
#pragma unroll
                    for (int n = 0; n < 2; ++n) acc[a][b][m][n] = (f32x4){0.f, 0.f, 0.f, 0.f};
        cur = nxt; cA = nA; cB = nB; ++ui;
        if constexpr (ALIGN_EPI) { if (wr == 1) PG8_BAR; }
    }
    PG8_WAIT_V(0);
    if constexpr (!ALIGN_EPI) { if (wr == 0) PG8_BAR; }
    PG8_BAR;
    if constexpr (Epi::AFTER_DRAIN) { E.fused(acc, cur, wr, wc, fr, fq, lds, wid, lane); S.done(cur); }
#undef PG8_SA
#undef PG8_SB
#undef PG8_STAGE
#undef PG8_LDA
#undef PG8_LDB
#undef PG8_MMA
#undef PG8_WAIT_V
#undef PG8_WAIT_L
#undef PG8_BAR
#undef PG8_SCHED
}
}
namespace att {
typedef unsigned short bf16_t;
typedef short bf16x8 __attribute__((ext_vector_type(8)));
typedef short s16x4 __attribute__((ext_vector_type(4)));
typedef float f32x16 __attribute__((ext_vector_type(16)));
typedef unsigned u32x4 __attribute__((ext_vector_type(4)));
#define ALAS __attribute__((address_space(3)))
#define SBAR() __builtin_amdgcn_sched_barrier(0)
constexpr int SHM_V = 64 * 128 * 2;
constexpr int LDS_K0 = 2 * SHM_V;
__device__ __forceinline__ int v_st(int k, int c) { const int kk = (k & ~0xC) | ((k & 4) << 1) | ((k & 8) >> 1); return ((kk >> 3) * 4 + (c >> 5)) * 512 + ((kk & 7) * 32 + (c & 31)) * 2; }
__device__ __forceinline__ int v_rd_base(int lane) { return ((lane & 3) << 3) | (((lane >> 2) & 3) << 6) | (((lane >> 4) & 1) << 5) | (((lane >> 5) & 1) << 8); }
constexpr int v_rd_off(int d0, int ks, int half) { return d0 * 512 + ks * 4096 + half * 2048; }
__device__ __forceinline__ int crow(int r, int hi) { return (r & 3) + 8 * (r >> 2) + 4 * hi; }
__device__ __forceinline__ unsigned cvtpk(float lo, float hi) { unsigned r; asm volatile("v_cvt_pk_bf16_f32 %0, %1, %2" : "=v"(r) : "v"(lo), "v"(hi)); return r; }
__device__ __forceinline__ void mask_half(f32x16& p, int dq) {
    const float NEG = -__builtin_inff();
#pragma unroll
    for (int r = 0; r < 16; ++r) { const int c = (r & 3) + 8 * (r >> 2); if (dq - c < 0) p[r] = NEG; }
}
__device__ __forceinline__ void softmax_half(f32x16& p, float& m_reg, float& alpha, const float C2) {
    float pmax = fmaxf(p[0], p[1]);
#pragma unroll
    for (int r = 2; r < 16; ++r) pmax = fmaxf(pmax, p[r]);
    { auto rr = __builtin_amdgcn_permlane32_swap(__float_as_uint(pmax), __float_as_uint(pmax), false, false); pmax = fmaxf(__uint_as_float(rr[0]), __uint_as_float(rr[1])); }
    float mn;
    if (__builtin_expect(__all((pmax - m_reg) * C2 <= 11.5f), 1)) { mn = m_reg; alpha = 1.f; }
    else { mn = fmaxf(m_reg, pmax); alpha = __builtin_amdgcn_exp2f((m_reg - mn) * C2); m_reg = mn; }
    const float mnL = -mn * C2;
#pragma unroll
    for (int r = 0; r < 16; ++r) p[r] = __builtin_amdgcn_exp2f(fmaf(p[r], C2, mnL));
}
__device__ __forceinline__ void pack_half(const f32x16& p, float alpha, float& l_reg, bf16x8& pa0, bf16x8& pa1) {
    float ps = 0;
#pragma unroll
    for (int r = 0; r < 16; ++r) ps += p[r];
    { auto rr = __builtin_amdgcn_permlane32_swap(__float_as_uint(ps), __float_as_uint(ps), false, false); ps = __uint_as_float(rr[0]) + __uint_as_float(rr[1]); }
    l_reg = l_reg * alpha + ps;
#define PK4(P, B_, OUT) do { unsigned a0 = cvtpk(P[B_+0], P[B_+1]), a1 = cvtpk(P[B_+2], P[B_+3]);                          \
        unsigned b0 = cvtpk(P[B_+4], P[B_+5]), b1 = cvtpk(P[B_+6], P[B_+7]);                                             \
        auto r0 = __builtin_amdgcn_permlane32_swap(a0, b0, false, false); auto r1 = __builtin_amdgcn_permlane32_swap(a1, b1, false, false); \
        u32x4 w = {r0[0], r1[0], r0[1], r1[1]}; OUT = __builtin_bit_cast(bf16x8, w); } while (0)
    PK4(p, 0, pa0); PK4(p, 8, pa1);
#undef PK4
}
template <int DQK, int KB, int HALF>
__device__ __forceinline__ void qkt_half(f32x16& p, const ALAS char* K_lds, int r32, int hi, const bf16x8* qr) {
    constexpr int RP = DQK * 2, SHM_K = 64 * RP, ND = DQK / 16;
    p = f32x16{};
    const ALAS char* kb[4];
#pragma unroll
    for (int dd = 0; dd < 4; ++dd) kb[dd] = K_lds + KB * SHM_K + HALF * 32 * RP + r32 * RP + (((dd * 2 + hi) ^ (r32 & 7)) << 4);
#pragma unroll
    for (int dg = 0; dg < ND / 4; ++dg) {
        bf16x8 b0[4];
#pragma unroll
        for (int dd = 0; dd < 4; ++dd) b0[dd] = *(const ALAS bf16x8*)(kb[dd] + dg * 128);
#pragma unroll
        for (int dd = 0; dd < 4; ++dd) p = __builtin_amdgcn_mfma_f32_32x32x16_bf16(b0[dd], qr[dg * 4 + dd], p, 0, 0, 0);
    }
}
template <int VB, int HALF>
__device__ __forceinline__ void pv_half(f32x16* o, int vb0, bf16x8 pa0, bf16x8 pa1) {
#define TRRD(dst, off) asm volatile("ds_read_b64_tr_b16 %0, %1 offset:%2" : "=&v"(dst) : "v"(vb0), "i"(off) : "memory")
#define PV_KS(ks, pa) do { s16x4 l0, l1, l2, l3, h0, h1, h2, h3; constexpr int b_ = VB * SHM_V + (ks) * 4096; \
        TRRD(l0, b_); TRRD(h0, b_ + 2048); TRRD(l1, b_ + 512); TRRD(h1, b_ + 512 + 2048); TRRD(l2, b_ + 1024); TRRD(h2, b_ + 1024 + 2048); TRRD(l3, b_ + 1536); TRRD(h3, b_ + 1536 + 2048); \
        asm volatile("s_waitcnt lgkmcnt(0)" ::: "memory"); SBAR();   \
        o[0] = __builtin_amdgcn_mfma_f32_32x32x16_bf16(pa, (bf16x8){l0[0], l0[1], l0[2], l0[3], h0[0], h0[1], h0[2], h0[3]}, o[0], 0, 0, 0);   \
        o[1] = __builtin_amdgcn_mfma_f32_32x32x16_bf16(pa, (bf16x8){l1[0], l1[1], l1[2], l1[3], h1[0], h1[1], h1[2], h1[3]}, o[1], 0, 0, 0);   \
        o[2] = __builtin_amdgcn_mfma_f32_32x32x16_bf16(pa, (bf16x8){l2[0], l2[1], l2[2], l2[3], h2[0], h2[1], h2[2], h2[3]}, o[2], 0, 0, 0);   \
        o[3] = __builtin_amdgcn_mfma_f32_32x32x16_bf16(pa, (bf16x8){l3[0], l3[1], l3[2], l3[3], h3[0], h3[1], h3[2], h3[3]}, o[3], 0, 0, 0); } while (0)
    PV_KS(2 * HALF, pa0); PV_KS(2 * HALF + 1, pa1);
#undef PV_KS
#undef TRRD
}

template <int DQK> constexpr int lds_bytes() { return 2 * SHM_V + 2 * 64 * DQK * 2 + 8 * 256; }

template <int DQK>
__device__ __forceinline__ void attn_unit(const bf16_t* __restrict__ Q, int qp, const bf16_t* __restrict__ K, int kp, const bf16_t* __restrict__ V, int vp, bf16_t* __restrict__ O, int op, int qb, const float C2, char* lds) {
    constexpr int RP = DQK * 2, SHM_K = 64 * RP, ND = DQK / 16, CH = DQK / 8, NKC = (64 * CH) / 512;
    int tid_ = threadIdx.x; asm volatile("" : "+v"(tid_));
    const int tid = tid_, wid = __builtin_amdgcn_readfirstlane(tid >> 6), lane = tid & 63, r32 = lane & 31, hi = lane >> 5;
    const int q0 = qb * 256 + wid * 32, NT = 4 * (qb + 1);
    ALAS char* V_lds = (ALAS char*)lds; ALAS char* K_lds = V_lds + LDS_K0;
    ALAS float* wsf = (ALAS float*)(K_lds + 2 * SHM_K) + wid * 64; ALAS float* li_l = wsf; ALAS float* al_l = wsf + 32;
    bf16x8 qr[ND];
    { const char* qbase = (const char*)Q + (size_t)q0 * qp * 2; const unsigned qo = (unsigned)(r32 * qp + hi * 8) * 2u;
#pragma unroll
      for (int d0 = 0; d0 < ND; ++d0) qr[d0] = *(const bf16x8*)(qbase + qo + d0 * 32); }
    unsigned koff[NKC]; int klds[NKC];
#pragma unroll
    for (int i = 0; i < NKC; ++i) { const int id = tid + 512 * i, row = id / CH, c = id % CH; koff[i] = (unsigned)(row * kp + c * 8) * 2u; klds[i] = row * RP + ((c ^ (row & 7)) << 4); }
    const int sr = tid >> 4, sc = (tid & 15) * 8, vst0 = v_st(sr, sc), vst1 = v_st(32 + sr, sc);
    const unsigned voff0 = (unsigned)(sr * vp + sc) * 2u, voff1 = (unsigned)((32 + sr) * vp + sc) * 2u;
    const int vb0 = (int)(uintptr_t)lds + v_rd_base(lane);
    bf16x8 stk[NKC], stv0, stv1;
#define LOADT(t) do { const char* kt_ = (const char*)K + (size_t)(t) * 64 * kp * 2; const char* vt_ = (const char*)V + (size_t)(t) * 64 * vp * 2; \
        _Pragma("unroll") for (int i = 0; i < NKC; ++i) stk[i] = *(const bf16x8*)(kt_ + koff[i]); \
        stv0 = *(const bf16x8*)(vt_ + voff0); stv1 = *(const bf16x8*)(vt_ + voff1); } while (0)
#define WRITET(b) do { _Pragma("unroll") for (int i = 0; i < NKC; ++i) *(ALAS bf16x8*)(K_lds + (b) * SHM_K + klds[i]) = stk[i]; \
        *(ALAS bf16x8*)(V_lds + (b) * SHM_V + vst0) = stv0; *(ALAS bf16x8*)(V_lds + (b) * SHM_V + vst1) = stv1; } while (0)
    float m_reg = -1e30f, l_reg = 0.f; f32x16 o[4] = {};
    f32x16 p; bf16x8 pa0, pa1;
    LOADT(0); WRITET(0); __syncthreads();
#define HALFSTEP(kb_, b, h) do { if ((kb_) + 32 * (h) <= q0 + 31) { \
            qkt_half<DQK, b, h>(p, K_lds, r32, hi, qr); \
            if ((kb_) + 32 * (h) + 31 > q0) mask_half(p, q0 + r32 - 4 * hi - (kb_) - 32 * (h)); \
            float alpha; softmax_half(p, m_reg, alpha, C2); \
            if (__any(alpha < 1.f)) { if (hi == 0) al_l[r32] = alpha; asm volatile("s_waitcnt lgkmcnt(0)" ::: "memory"); \
                _Pragma("unroll") for (int d_ = 0; d_ < 4; ++d_) _Pragma("unroll") for (int r = 0; r < 16; ++r) o[d_][r] *= al_l[crow(r, hi)]; } \
            pack_half(p, alpha, l_reg, pa0, pa1); SBAR(); \
            pv_half<b, h>(o, vb0, pa0, pa1); } } while (0)
#define STEP(t, b) do { const int kbs_ = (t) * 64; \
        if ((t) + 1 < NT) { LOADT((t) + 1); } SBAR(); \
        HALFSTEP(kbs_, b, 0); SBAR(); HALFSTEP(kbs_, b, 1); \
        SBAR(); if ((t) + 1 < NT) { WRITET((b) ^ 1); } \
        __syncthreads(); } while (0)
    for (int t = 0; t < NT; t += 2) { STEP(t, 0); STEP(t + 1, 1); }
#undef STEP
#undef HALFSTEP
#undef LOADT
#undef WRITET
    if (hi == 0) li_l[r32] = l_reg; asm volatile("s_waitcnt lgkmcnt(0)" ::: "memory");
    float rli[16];
#pragma unroll
    for (int r = 0; r < 16; ++r) rli[r] = __builtin_amdgcn_rcpf(li_l[crow(r, hi)]);
    char* Ow = (char*)O + (size_t)(qb * 256 + wid * 32) * op * 2; const unsigned oo = (unsigned)(4 * hi * op + r32) * 2u;
#pragma unroll
    for (int r = 0; r < 16; ++r) { const int cr = (r & 3) + 8 * (r >> 2);
#pragma unroll
        for (int d0 = 0; d0 < 4; ++d0) { const float v = o[d0][r] * rli[r]; const float vn = __shfl_xor(v, 1);
            if ((r32 & 1) == 0) *(unsigned*)(Ow + (size_t)(cr * op + d0 * 32) * 2 + oo) = cvtpk(v, vn); } }
    __syncthreads();
}
#undef SBAR
}

#define GAS __attribute__((address_space(1)))
#define LAS __attribute__((address_space(3)))
typedef unsigned short bf16;
typedef unsigned v4u __attribute__((ext_vector_type(4)));
typedef float f32x4 __attribute__((ext_vector_type(4)));
typedef short bf16x8 __attribute__((ext_vector_type(8)));
typedef GAS unsigned gu32;
typedef GAS unsigned long long gu64;
#define RLX_AGENT __ATOMIC_RELAXED, __HIP_MEMORY_SCOPE_AGENT
#define LDS_WAIT() asm volatile("s_waitcnt lgkmcnt(0)" ::: "memory")
#define VM_WAIT() asm volatile("s_waitcnt vmcnt(0)" ::: "memory")
__device__ __forceinline__ unsigned long long rt() { return __builtin_amdgcn_s_memrealtime(); }
__device__ __forceinline__ unsigned f2bf(float f) { unsigned u = __builtin_bit_cast(unsigned, f); return (u + 0x7fffu + ((u >> 16) & 1u)) >> 16; }
__device__ __forceinline__ unsigned pk2(float lo, float hi) { return f2bf(lo) | (f2bf(hi) << 16); }

typedef float f32x2 __attribute__((ext_vector_type(2)));
#define XB_TMO      128
#define XB_XCNT(j)  (256  + 64 * (j))
#define XB_XSUB(j)  (1280 + 64 * (j))
#define XB_XGEN(j)  (2304 + 64 * (j))
#define XB_TOP      3328
#define XB_TOPGEN   3392
#define XCD_BAR_WORDS 3456
#define XB_SPIN_CAP (1u << 18)

__device__ __forceinline__ unsigned xb_ld(unsigned* p)              { return __hip_atomic_load(p, __ATOMIC_RELAXED, __HIP_MEMORY_SCOPE_AGENT); }
__device__ __forceinline__ unsigned xb_add(unsigned* p, unsigned v) { return __hip_atomic_fetch_add(p, v, __ATOMIC_RELAXED, __HIP_MEMORY_SCOPE_AGENT); }
__device__ __forceinline__ unsigned xb_xcc_id() { return (unsigned)__builtin_amdgcn_s_getreg((3 << 11) | 20) & 0xFu; }
#define XB_SPIN(cond, bar) do { unsigned _sp = 0; while (cond) { __builtin_amdgcn_s_sleep(1); \
    if ((++_sp & 255u) == 0u) { if (xb_ld(&(bar)[XB_TMO])) break; if (_sp > XB_SPIN_CAP) { atomicAdd(&(bar)[XB_TMO], 1u); break; } } } } while (0)

struct XcdBarrier {
    unsigned* bar; unsigned x;
    volatile LAS unsigned* st;
};

__device__ __forceinline__ XcdBarrier xcd_barrier_post(unsigned* bar, volatile LAS unsigned* st) {
    XcdBarrier b; b.bar = bar; b.x = xb_xcc_id(); b.st = st;
    if (threadIdx.x == 0) (void)xb_add(&bar[XB_XCNT(b.x)], 1u);
    return b;
}
__device__ __forceinline__ void xcd_barrier_complete(unsigned* bar, unsigned x, unsigned& nloc, unsigned& nx) {
    const unsigned G = gridDim.x * gridDim.y * gridDim.z;
    unsigned sum, cnt, mine, sp = 0u;
    for (;;) {
        sum = 0u; cnt = 0u; mine = 0u;
#pragma unroll
        for (unsigned j = 0; j < 16; ++j) { const unsigned c = xb_ld(&bar[XB_XCNT(j)]); sum += c; cnt += (c > 0u) ? 1u : 0u; mine = (j == x) ? c : mine; }
        if (sum == G) break;
        __builtin_amdgcn_s_sleep(1);
        if ((++sp & 255u) == 0u) { if (xb_ld(&bar[XB_TMO])) break; if (sp > XB_SPIN_CAP) { atomicAdd(&bar[XB_TMO], 1u); break; } }
    }
    nloc = mine > 0u ? mine : 1u; nx = cnt > 0u ? cnt : 1u;
}

__device__ __forceinline__ void xcd_barrier(const XcdBarrier& b) {
    asm volatile("s_waitcnt vmcnt(0)" ::: "memory");
    __syncthreads();
    if (threadIdx.x == 0) {
        unsigned* bar = b.bar;
        __builtin_amdgcn_s_waitcnt(0);
        unsigned nloc = b.st[0], nx = b.st[1];
        if (nloc == 0u) { xcd_barrier_complete(bar, b.x, nloc, nx); b.st[0] = nloc; b.st[1] = nx; }
        const unsigned old = xb_add(&bar[XB_XSUB(b.x)], 1u);
        const unsigned gen = old / nloc;
        if (old + 1u == (gen + 1u) * nloc) {
            __builtin_amdgcn_fence(__ATOMIC_RELEASE, "agent");
            asm volatile("s_waitcnt vmcnt(0)" ::: "memory");
            const unsigned og = xb_add(&bar[XB_TOP], 1u);
            const unsigned tg = og / nx;
            if (og + 1u == (tg + 1u) * nx) xb_add(&bar[XB_TOPGEN], 1u);
            else XB_SPIN(xb_ld(&bar[XB_TOPGEN]) == tg, bar);
            __builtin_amdgcn_fence(__ATOMIC_ACQUIRE, "agent");
            xb_add(&bar[XB_XGEN(b.x)], 1u);
            asm volatile("s_waitcnt vmcnt(0)" ::: "memory");
        } else {
            XB_SPIN(xb_ld(&bar[XB_XGEN(b.x)]) == gen, bar);
            __builtin_amdgcn_fence(__ATOMIC_ACQUIRE, "agent");
            asm volatile("s_waitcnt vmcnt(0)" ::: "memory");
        }
    }
    __syncthreads();
}
constexpr int NWAVES = 8;
#ifndef MK_N_LAUNCHES
#define MK_N_LAUNCHES 1
#endif
constexpr int NPH = 18;
#ifndef ONLY_PH
#define ONLY_PH -1
#endif
#define PH_ON(n) (ONLY_PH < 0 || ONLY_PH == (n))
static_assert(MK_N_LAUNCHES == 1 || MK_N_LAUNCHES == NPH, "MK_N_LAUNCHES is 1 or 18");

constexpr int BATCH = 8, SEQ = 4096, DM = 1024, M = BATCH * SEQ, DFF = 2816;
constexpr float ALPHA = 1.4142135623730951f;
constexpr float LN_EPS = 1e-5f, RMS_EPS = 1e-6f;
constexpr float LAMBDA_INIT = 0.35550906759096934f;
constexpr float C2_MLA = 0.07216878364870322f * 1.4426950408889634f;
constexpr float C2_DIFF = 0.125f * 1.4426950408889634f;
__device__ const float ROPE_INV[32] = {1.000000000e+00f, 7.498942018e-01f, 5.623413324e-01f, 4.216965139e-01f, 3.162277639e-01f, 2.371373922e-01f, 1.778279394e-01f, 1.333521456e-01f,
    1.000000015e-01f, 7.498941571e-02f, 5.623412877e-02f, 4.216964915e-02f, 3.162277862e-02f, 2.371373586e-02f, 1.778279431e-02f, 1.333521493e-02f,
    9.999999776e-03f, 7.498942316e-03f, 5.623413250e-03f, 4.216964822e-03f, 3.162277862e-03f, 2.371373819e-03f, 1.778279431e-03f, 1.333521446e-03f,
    1.000000047e-03f, 7.498941850e-04f, 5.623413017e-04f, 4.216965463e-04f, 3.162277862e-04f, 2.371373848e-04f, 1.778279402e-04f, 1.333521504e-04f};

constexpr size_t MiB = 1u << 20;
constexpr size_t WS_CTL = 0, CTL_ZERO_BYTES = 1 * MiB;
constexpr size_t WS_COS = 1 * MiB, WS_SIN = 1 * MiB + 512 * 1024;
constexpr size_t WS_W = 2 * MiB;
constexpr size_t WO_1 = 0, WO_2 = 786432, WO_3 = 1376256, WO_4 = 1900544, WO_5A = 2949120, WO_6A = 8716288, WO_7 = 11599872, WO_8 = 14745600, WO_5B = 15794176, WO_6B = 21561344, WO_END = 24444928;
static_assert(WS_W + WO_END * 2 <= 64 * MiB, "weights");
constexpr size_t WS_HB = 64 * MiB;
constexpr size_t WS_G1OUT = 128 * MiB;
constexpr size_t WS_CQN = 224 * MiB, WS_CN = 248 * MiB;
constexpr size_t WS_KFULL = 264 * MiB;
constexpr size_t WS_VB = 360 * MiB;
constexpr size_t WS_QB = 128 * MiB;
constexpr size_t WS_OB = 424 * MiB;
constexpr size_t WS_ACT = 128 * MiB;
constexpr size_t WS_KVQ = 128 * MiB;
constexpr size_t WS_O2 = 320 * MiB;
constexpr size_t WS_OD = 448 * MiB;
constexpr size_t WS_END = 512 * MiB;
constexpr int CW_BAR = 4096;

constexpr int RING_OFF = 0, RING_BYTES = 131072;
constexpr int LDSCTL_OFF = RING_BYTES, MISC_OFF = LDSCTL_OFF + 320;
constexpr int LDS_BYTES = 147456;
static_assert(att::lds_bytes<192>() <= RING_BYTES && pg8::STAGE_BYTES <= RING_BYTES, "LDS");

struct Args { const float* in[22]; float* out; unsigned char* ws; int ph_lo, ph_hi, li, pad; };

__device__ __forceinline__ float wave_sum(float v) {
#pragma unroll
    for (int o = 1; o < 64; o <<= 1) v += __shfl_xor(v, o);
    return v;
}
__device__ __forceinline__ float bf2f(unsigned short b) { return __uint_as_float((unsigned)b << 16); }

__device__ __forceinline__ void sincos_acc(float ang, float& c, float& s) {
    const double a = (double)ang, k = __builtin_rint(a * 0.15915494309189535), r = a - k * 6.283185307179586, r2 = r * r;
    double tc = 1.0, sc = 1.0, ts = 1.0, ss = 1.0;
#pragma unroll
    for (int n = 1; n <= 14; ++n) { tc *= -r2 * (1.0 / (double)((2 * n - 1) * (2 * n))); sc += tc; ts *= -r2 * (1.0 / (double)((2 * n) * (2 * n + 1))); ss += ts; }
    c = (float)sc; s = (float)(r * ss);
}

__device__ __forceinline__ void transpose_item(const float* W, int K, int N, int csrc, bf16* WT, int nphys0, int k0, LAS float* scr, int lane) {
    if (W) {
#pragma unroll 8
        for (int i = 0; i < 32; ++i) { const int kk = 2 * i + (lane >> 5); scr[kk * 33 + (lane & 31)] = W[(size_t)(k0 + kk) * N + csrc + (lane & 31)]; }
    } else {
#pragma unroll 8
        for (int i = 0; i < 32; ++i) { const int kk = 2 * i + (lane >> 5); scr[kk * 33 + (lane & 31)] = 0.f; }
    }
    LDS_WAIT(); asm volatile("" ::: "memory");
    const int c = lane & 7;
#pragma unroll
    for (int j = 0; j < 4; ++j) { const int n = (lane >> 3) + 8 * j; const LAS float* s = scr + (8 * c) * 33 + n;
        v4u o; o.x = pk2(s[0 * 33], s[1 * 33]); o.y = pk2(s[2 * 33], s[3 * 33]); o.z = pk2(s[4 * 33], s[5 * 33]); o.w = pk2(s[6 * 33], s[7 * 33]);
        *(v4u*)(WT + (size_t)(nphys0 + n) * K + k0 + 8 * c) = o; }
    LDS_WAIT(); asm volatile("" ::: "memory");
}

__global__ void __launch_bounds__(NWAVES * 64, 2) mk_fwd(Args args) {
    extern __shared__ __attribute__((aligned(16))) unsigned char lds[];
    LAS unsigned char* ldsl = (LAS unsigned char*)lds;
    volatile LAS unsigned* MISC = (volatile LAS unsigned*)(ldsl + MISC_OFF);
    const int tid0 = threadIdx.x, wave = __builtin_amdgcn_readfirstlane(tid0 >> 6);
    const int G = gridDim.x; const int bx = blockIdx.x; const int vcu = (G % 8 == 0) ? (bx % 8) * (G / 8) + bx / 8 : bx;
    const int gw = vcu * NWAVES + wave, NGW = G * NWAVES;
    unsigned* ctl = (unsigned*)(args.ws + WS_CTL);
    for (int u = tid0; u < (LDS_BYTES - LDSCTL_OFF) / 4; u += NWAVES * 64) ((LAS unsigned*)(ldsl + LDSCTL_OFF))[u] = 0u;
    __syncthreads();
    XcdBarrier bar; bar.bar = ctl + CW_BAR; bar.x = 0; bar.st = nullptr;
    if (MK_N_LAUNCHES == 1) bar = xcd_barrier_post(ctl + CW_BAR, MISC + 8);
    cg::grid_group grid = cg::this_grid();

    for (int ph = args.ph_lo; ph < args.ph_hi; ++ph) {
        int tid = tid0; asm volatile("" : "+v"(tid)); const int lane = tid & 63;
        unsigned char* ws_ = args.ws; asm volatile("" : "+s"(ws_)); GAS unsigned char* ws = (GAS unsigned char*)ws_;
        float* cosT = (float*)(ws + WS_COS); float* sinT = (float*)(ws + WS_SIN);
        bf16* Wb = (bf16*)(ws + WS_W);
        bf16* HB = (bf16*)(ws + WS_HB);
        float* G1OUT = (float*)(ws + WS_G1OUT);
        bf16* CQN = (bf16*)(ws + WS_CQN); bf16* CN = (bf16*)(ws + WS_CN);
        bf16* KFULL = (bf16*)(ws + WS_KFULL); bf16* VB = (bf16*)(ws + WS_VB); bf16* QB = (bf16*)(ws + WS_QB); bf16* OB = (bf16*)(ws + WS_OB);
        bf16* ACT = (bf16*)(ws + WS_ACT); bf16* KVQ = (bf16*)(ws + WS_KVQ); bf16* O2 = (bf16*)(ws + WS_O2); bf16* OD = (bf16*)(ws + WS_OD);
        float* T = args.out;
        switch (ph) {
        case 0: if (PH_ON(0)) {
            LAS float* scr = (LAS float*)(ldsl + RING_OFF + wave * 16384);
            constexpr int NMAT = 10;
            const int Kd[NMAT] = {1024, 384, 256, 1024, 1024, 2816, 1024, 1024, 1024, 2816};
            const int Np[NMAT] = {768, 1536, 2048, 1024, 5632, 1024, 3072, 1024, 5632, 1024};
            const size_t Wo[NMAT] = {WO_1, WO_2, WO_3, WO_4, WO_5A, WO_6A, WO_7, WO_8, WO_5B, WO_6B};
            constexpr int NITEMS = 11936;
            for (int it = gw; it < NITEMS; it += NGW) {
                int r = it, mat = 0;
#pragma unroll
                for (int q = 0; q < NMAT; ++q) { const int cnt = (Kd[q] / 64) * (Np[q] / 32); if (mat == q && r >= cnt) { r -= cnt; mat = q + 1; } }
                int K = 0, N = 0; size_t wo = 0;
#pragma unroll
                for (int q = 0; q < NMAT; ++q) if (mat == q) { K = Kd[q]; N = Np[q]; wo = Wo[q]; }
                const int nblk = N / 32, kb = r / nblk, pb = r % nblk;
                const int pn = pb >> 3, bj = (pb >> 2) & 1, g = pb & 3, paired = 256 * pn + 64 * g + 32 * bj;
                const float* src = nullptr; int sN = 0, col = 0;
                switch (mat) {
                case 0: if (pb < 12) { src = args.in[1]; sN = 384; col = 32 * pb; } else if (pb < 22) { src = args.in[4]; sN = 320; col = 32 * (pb - 12); } break;
                case 1: src = args.in[3]; sN = 1536; col = paired; break;
                case 2: src = args.in[6]; sN = 2048; col = paired; break;
                case 3: src = args.in[7]; sN = 1024; col = 32 * pb; break;
                case 4: src = args.in[20]; sN = 5632; col = bj ? (DFF + 128 * pn + 32 * g) : (128 * pn + 32 * g); break;
                case 8: src = args.in[20] + (size_t)1024 * 5632; sN = 5632; col = bj ? (DFF + 128 * pn + 32 * g) : (128 * pn + 32 * g); break;
                case 5: src = args.in[21]; sN = 1024; col = 32 * pb; break;
                case 9: src = args.in[21] + (size_t)DFF * 1024; sN = 1024; col = 32 * pb; break;
                case 6: if (paired < 2048) { src = args.in[8]; sN = 2048; col = paired; } else { src = args.in[9]; sN = 1024; col = paired - 2048; } break;
                default: src = args.in[15]; sN = 1024; col = 32 * pb; break;
                }
                transpose_item(src, K, sN, col, Wb + wo, 32 * pb, 64 * kb, scr, lane);
            }
            {
                const f32x4* x4 = (const f32x4*)args.in[0]; v4u* o = (v4u*)HB;
                for (int i = bx * 512 + tid; i < M * DM / 8; i += G * 512) { const f32x4 a = x4[2 * i], b = x4[2 * i + 1];
                    v4u w; w.x = pk2(a[0], a[1]); w.y = pk2(a[2], a[3]); w.z = pk2(b[0], b[1]); w.w = pk2(b[2], b[3]); o[i] = w; }
            }
            for (int i = bx * 512 + tid; i < SEQ * 32; i += G * 512) { float c, s; sincos_acc((float)(i >> 5) * ROPE_INV[i & 31], c, s); cosT[i] = c; sinT[i] = s; }
        } break;
        case 1: case 5: case 8: case 13: case 16: if (PH_ON(1)) {
            pg8::Gemm g; pg8::EpiF32 E;
            if (ph == 1) { g = pg8::Gemm{HB, Wb + WO_1, M, 768, 1024}; E = pg8::EpiF32{G1OUT, nullptr, 768, 0.f}; }
            else if (ph == 5) { g = pg8::Gemm{OB, Wb + WO_4, M, 1024, 1024}; E = pg8::EpiF32{T, args.in[0], 1024, ALPHA}; }
            else if (ph == 8) { g = pg8::Gemm{ACT, Wb + WO_6A, M, 1024, DFF}; E = pg8::EpiF32{T, T, 1024, ALPHA}; }
            else if (ph == 13) { g = pg8::Gemm{OD, Wb + WO_8, M, 1024, 1024}; E = pg8::EpiF32{T, T, 1024, ALPHA}; }
            else { g = pg8::Gemm{ACT, Wb + WO_6B, M, 1024, DFF}; E = pg8::EpiF32{T, T, 1024, ALPHA}; }
            pg8::StaticOrder S; S.init(g.M, g.N, G, bx);
            pg8::gemm_phase<pg8::EpiF32, pg8::StaticOrder, true, true>(ldsl + RING_OFF, g, S, E);
        } break;
        case 2: if (PH_ON(2)) {
            const float* qn = args.in[2]; const float* kn = args.in[5];
            for (int row = gw; row < M; row += NGW) {
                const float* g1 = G1OUT + (size_t)row * 768;
                f32x2 c[3]; float ss = 0.f;
#pragma unroll
                for (int j = 0; j < 3; ++j) { c[j] = *(const f32x2*)(g1 + 2 * lane + 128 * j); ss += c[j].x * c[j].x + c[j].y * c[j].y; }
                f32x2 d[2]; float s2 = 0.f;
#pragma unroll
                for (int j = 0; j < 2; ++j) { d[j] = *(const f32x2*)(g1 + 384 + 2 * lane + 128 * j); s2 += d[j].x * d[j].x + d[j].y * d[j].y; }
                const float xr = g1[640 + lane];
                const float r1 = 1.f / sqrtf(wave_sum(ss) * (1.f / 384.f) + RMS_EPS), r2 = 1.f / sqrtf(wave_sum(s2) * (1.f / 256.f) + RMS_EPS);
#pragma unroll
                for (int j = 0; j < 3; ++j) { const f32x2 w = *(const f32x2*)(qn + 2 * lane + 128 * j); *(unsigned*)(CQN + (size_t)row * 384 + 2 * lane + 128 * j) = pk2(c[j].x * r1 * w.x, c[j].y * r1 * w.y); }
#pragma unroll
                for (int j = 0; j < 2; ++j) { const f32x2 w = *(const f32x2*)(kn + 2 * lane + 128 * j); *(unsigned*)(CN + (size_t)row * 256 + 2 * lane + 128 * j) = pk2(d[j].x * r2 * w.x, d[j].y * r2 * w.y); }
                const float xp = __shfl_xor(xr, 32); const int pos = row & (SEQ - 1), dd = lane & 31;
                const float cs = cosT[pos * 32 + dd], sn = sinT[pos * 32 + dd];
                const float ov = lane < 32 ? xr * cs - xp * sn : xr * cs + xp * sn;
                const float on = __shfl_xor(ov, 1);
                if ((lane & 1) == 0) { const unsigned w = pk2(ov, on);
#pragma unroll
                    for (int h = 0; h < 8; ++h) *(unsigned*)(KFULL + (size_t)row * 1536 + h * 192 + 128 + lane) = w; }
            }
        } break;
        case 3: case 10: if (PH_ON(3)) {
            const int j0 = ph == 3 ? 0 : 2, j1 = ph == 3 ? 2 : 3;
            for (int j = j0; j < j1; ++j) {
                pg8::Gemm g; pg8::EpiPair E;
                if (j == 0) { g = pg8::Gemm{CQN, Wb + WO_2, M, 1536, 384}; E = pg8::EpiPair{0, QB, nullptr, cosT, sinT}; }
                else if (j == 1) { g = pg8::Gemm{CN, Wb + WO_3, M, 2048, 256}; E = pg8::EpiPair{1, KFULL, VB, cosT, sinT}; }
                else { g = pg8::Gemm{HB, Wb + WO_7, M, 3072, 1024}; E = pg8::EpiPair{2, KVQ, nullptr, cosT, sinT}; }
                pg8::StaticOrder S; S.init(g.M, g.N, G, bx);
                pg8::gemm_phase<pg8::EpiPair, pg8::StaticOrder, true, true>(ldsl + RING_OFF, g, S, E);
            }
        } break;
        case 4: if (PH_ON(4)) {
            for (int L = vcu; L < 64 * 8; L += G) { const int bh = L >> 3, s = L & 7, b = bh >> 3, h = bh & 7;
                const bf16* Qp = QB + (size_t)b * SEQ * 1536 + h * 192; const bf16* Kp = KFULL + (size_t)b * SEQ * 1536 + h * 192;
                const bf16* Vp = VB + (size_t)b * SEQ * 1024 + h * 128; bf16* Op = OB + (size_t)b * SEQ * 1024 + h * 128;
                for (int pass = 0; pass < 2; ++pass) att::attn_unit<192>(Qp, 1536, Kp, 1536, Vp, 1024, Op, 1024, pass ? s : 15 - s, C2_MLA, (char*)lds + RING_OFF); }
        } break;
        case 11: if (PH_ON(11)) {
            for (int L = vcu; L < 128 * 8; L += G) { const int bv = L >> 3, s = L & 7, b = bv >> 4, vh = bv & 15;
                const bf16* base = KVQ + (size_t)b * SEQ * 3072;
                bf16* Op = O2 + (size_t)(vh & 1) * M * 1024 + (size_t)b * SEQ * 1024 + (vh >> 1) * 128;
                for (int pass = 0; pass < 2; ++pass) att::attn_unit<64>(base + 2048 + vh * 64, 3072, base + vh * 64, 3072, base + 1024 + (vh >> 1) * 128, 3072, Op, 1024, pass ? s : 15 - s, C2_DIFF, (char*)lds + RING_OFF); }
        } break;
        case 6: case 9: case 14: case 17: if (PH_ON(6)) {
            const int l = ph >= 14 ? 1 : 0; const bool first = (ph == 6 || ph == 14);
            const float* gam = (first ? args.in[16] : args.in[18]) + l * DM; const float* bet = (first ? args.in[17] : args.in[19]) + l * DM;
            f32x4 gv[4], bv[4];
#pragma unroll
            for (int j = 0; j < 4; ++j) { gv[j] = *(const f32x4*)(gam + 4 * lane + 256 * j); bv[j] = *(const f32x4*)(bet + 4 * lane + 256 * j); }
            for (int row = gw; row < M; row += NGW) {
                float* tr = T + (size_t)row * DM + 4 * lane;
                f32x4 v[4]; float s = 0.f;
#pragma unroll
                for (int j = 0; j < 4; ++j) { v[j] = *(const f32x4*)(tr + 256 * j); s += (v[j].x + v[j].y) + (v[j].z + v[j].w); }
                const float mean = wave_sum(s) * (1.f / DM); float s2 = 0.f;
#pragma unroll
                for (int j = 0; j < 4; ++j) { v[j] = v[j] - mean; s2 += (v[j].x * v[j].x + v[j].y * v[j].y) + (v[j].z * v[j].z + v[j].w * v[j].w); }
                const float rstd = 1.f / sqrtf(wave_sum(s2) * (1.f / DM) + LN_EPS);
#pragma unroll
                for (int j = 0; j < 4; ++j) { const f32x4 y = v[j] * rstd * gv[j] + bv[j]; *(f32x4*)(tr + 256 * j) = y;
                    if (ph != 17) { unsigned long long w = (unsigned long long)pk2(y.x, y.y) | ((unsigned long long)pk2(y.z, y.w) << 32); *(unsigned long long*)(HB + (size_t)row * DM + 4 * lane + 256 * j) = w; } }
            }
        } break;
        case 12: if (PH_ON(12)) {
            const float s1 = wave_sum(args.in[10][lane] * args.in[11][lane]), s2 = wave_sum(args.in[12][lane] * args.in[13][lane]);
            const float lam = expf(s1) - expf(s2) + LAMBDA_INIT;
            const int cc = (lane & 7) * 16; float sw[16];
#pragma unroll
            for (int j = 0; j < 16; ++j) sw[j] = args.in[14][cc + j] * (1.0f - LAMBDA_INIT);
            for (int row = gw; row < M; row += NGW) {
                const size_t off = (size_t)row * 1024 + (lane >> 3) * 128 + cc;
                const bf16x8 a0 = *(const bf16x8*)(O2 + off), a1 = *(const bf16x8*)(O2 + off + 8), b0 = *(const bf16x8*)(O2 + (size_t)M * 1024 + off), b1 = *(const bf16x8*)(O2 + (size_t)M * 1024 + off + 8);
                float o[16]; float ss = 0.f;
#pragma unroll
                for (int j = 0; j < 8; ++j) { o[j] = bf2f((unsigned short)a0[j]) - lam * bf2f((unsigned short)b0[j]); o[8 + j] = bf2f((unsigned short)a1[j]) - lam * bf2f((unsigned short)b1[j]); }
#pragma unroll
                for (int j = 0; j < 16; ++j) ss += o[j] * o[j];
                ss += __shfl_xor(ss, 1); ss += __shfl_xor(ss, 2); ss += __shfl_xor(ss, 4);
                const float rstd = 1.f / sqrtf(ss * (1.f / 128.f) + RMS_EPS);
                v4u w0, w1;
                w0.x = pk2(o[0] * rstd * sw[0], o[1] * rstd * sw[1]); w0.y = pk2(o[2] * rstd * sw[2], o[3] * rstd * sw[3]); w0.z = pk2(o[4] * rstd * sw[4], o[5] * rstd * sw[5]); w0.w = pk2(o[6] * rstd * sw[6], o[7] * rstd * sw[7]);
                w1.x = pk2(o[8] * rstd * sw[8], o[9] * rstd * sw[9]); w1.y = pk2(o[10] * rstd * sw[10], o[11] * rstd * sw[11]); w1.z = pk2(o[12] * rstd * sw[12], o[13] * rstd * sw[13]); w1.w = pk2(o[14] * rstd * sw[14], o[15] * rstd * sw[15]);
                *(v4u*)(OD + off) = w0; *(v4u*)(OD + off + 8) = w1;
            }
        } break;
        case 7: case 15: if (PH_ON(7)) {
            pg8::Gemm g{HB, Wb + (ph == 7 ? WO_5A : WO_5B), M, 2 * DFF, 1024}; pg8::EpiSwiglu E{ACT, DFF};
            pg8::StaticOrder S; S.init(g.M, g.N, G, bx);
            pg8::gemm_phase<pg8::EpiSwiglu, pg8::StaticOrder, true, true>(ldsl + RING_OFF, g, S, E);
        } break;
        default: break;
        }
        if (MK_N_LAUNCHES == 1 && ph + 1 < args.ph_hi) { if (ph == 0) grid.sync(); else xcd_barrier(bar); }
    }
}

extern "C" void kernel_launch(void* const* d_in, const int* in_sizes, int n_in, void* d_out, int out_size, void* d_ws, size_t ws_size, hipStream_t stream) {
    static int grid = 0;
    if (grid == 0) {
        if (n_in != 22 || in_sizes[0] != M * DM || out_size != M * DM || ws_size < WS_END) { fprintf(stderr, "kernel_launch: unexpected shapes (n_in %d, in0 %d, out %d, ws %zu); nothing launched\n", n_in, n_in > 0 ? in_sizes[0] : -1, out_size, ws_size); grid = -1; return; }
        int dev = 0, cus = 0, per_cu = 0;
        if (hipGetDevice(&dev) != hipSuccess || hipDeviceGetAttribute(&cus, hipDeviceAttributeMultiprocessorCount, dev) != hipSuccess) { fprintf(stderr, "kernel_launch: device query failed\n"); grid = -1; return; }
        if (hipFuncSetAttribute((const void*)mk_fwd, hipFuncAttributeMaxDynamicSharedMemorySize, LDS_BYTES) != hipSuccess) { fprintf(stderr, "kernel_launch: hipFuncSetAttribute failed\n"); grid = -1; return; }
        if (hipOccupancyMaxActiveBlocksPerMultiprocessor(&per_cu, (const void*)mk_fwd, NWAVES * 64, LDS_BYTES) != hipSuccess || per_cu < 1) { fprintf(stderr, "kernel_launch: occupancy query says %d\n", per_cu); per_cu = 1; }
        (void)hipGetLastError();
        grid = cus * 1;
    }
    if (grid < 0) return;
    if (hipMemsetAsync((char*)d_ws + WS_CTL, 0, CTL_ZERO_BYTES, stream) != hipSuccess) { fprintf(stderr, "kernel_launch: memset failed\n"); return; }
    Args a{};
    for (int i = 0; i < 22; ++i) a.in[i] = (const float*)d_in[i];
    a.out = (float*)d_out; a.ws = (unsigned char*)d_ws;
#if MK_N_LAUNCHES == 1
    a.ph_lo = 0; a.ph_hi = NPH; a.li = 0;
    void* kargs[] = {&a};
    const hipError_t e = hipLaunchCooperativeKernel((const void*)mk_fwd, dim3(grid), dim3(NWAVES * 64), kargs, LDS_BYTES, stream);
    if (e != hipSuccess) fprintf(stderr, "kernel_launch: cooperative launch failed: %s (grid %d)\n", hipGetErrorString(e), grid);
#else
    for (int ph = 0; ph < NPH; ++ph) { a.ph_lo = ph; a.ph_hi = ph + 1; a.li = ph; hipLaunchKernelGGL(mk_fwd, dim3(grid), dim3(NWAVES * 64), LDS_BYTES, stream, a); }
#endif
}
```

```cpp
#include <hip/hip_runtime.h>
#include <hip/hip_cooperative_groups.h>
#include <cstdio>
#include <cstdint>
namespace cg = cooperative_groups;
namespace pg8 {
#define PG8_LAS __attribute__((address_space(3)))
typedef unsigned short bf16_t;
typedef short bf16x8 __attribute__((ext_vector_type(8)));
typedef float f32x4 __attribute__((ext_vector_type(4)));
typedef unsigned u32x4 __attribute__((ext_vector_type(4)));
constexpr int BM = 256, BK = 64, HALF = 128, HTB = HALF * BK * 2  , STAGE_BYTES = 8 * HTB, NXCD = 8, WGM = 8;

__host__ __device__ __forceinline__ int lds_byte(int r, int c) { const int st = (r >> 4) * 2 + (c >> 5), rr = r & 15, cc = c & 31, ob = rr * 64 + cc * 2; return st * 1024 + (ob ^ (((ob >> 9) & 1) << 5)); }
__host__ __device__ __forceinline__ void stage_rc(int b, int& R, int& C) { const int st = b / 1024, sb = b % 1024, swz = sb ^ (((sb >> 9) & 1) << 5); R = (st >> 1) * 16 + swz / 64; C = (st & 1) * 32 + (swz % 64) / 2; }
__host__ __device__ __forceinline__ int perm32(int rho) { const int n = rho >> 4, i = rho & 15; return 8 * (i >> 2) + 4 * n + (i & 3); }

struct Unit { int pm, pn; };
struct Gemm { const bf16_t* A; const bf16_t* Bt; int M, N, K; };

struct StaticOrder {
    int nM, nN, nwg, G, c;
    __host__ __device__ void init(int M, int N, int G_, int c_) { nM = M / BM; nN = N / BM; nwg = nM * nN; G = G_; c = c_; }
    __host__ __device__ bool next(int i, Unit& u) const {
        const long L = (long)i * G + c; if (L >= nwg) return false;
        int wgid = (int)L; { const int q = nwg / NXCD, r = nwg % NXCD, xcd = wgid % NXCD, off = wgid / NXCD; wgid = (xcd < r ? xcd * (q + 1) : r * (q + 1) + (xcd - r) * q) + off; }
        const int nig = WGM * nN, gid = wgid / nig, fm = gid * WGM, gsz = (nM - fm) < WGM ? (nM - fm) : WGM;
        u.pm = fm + ((wgid % nig) % gsz); u.pn = (wgid % nig) / gsz; return true;
    }
    __device__ __forceinline__ void a_ready(const Unit&) const {}
    __device__ __forceinline__ void done(const Unit&) const {}
};
__device__ __forceinline__ unsigned cvt_pk_bf16(float lo, float hi) { unsigned r; asm volatile("v_cvt_pk_bf16_f32 %0, %1, %2" : "=v"(r) : "v"(lo), "v"(hi)); return r; }
typedef float f32x2 __attribute__((ext_vector_type(2)));
__device__ __forceinline__ u32x4 pack8(f32x4 a, f32x4 b) { u32x4 w; w.x = cvt_pk_bf16(a[0], a[1]); w.y = cvt_pk_bf16(a[2], a[3]); w.z = cvt_pk_bf16(b[0], b[1]); w.w = cvt_pk_bf16(b[2], b[3]); return w; }

struct EpiF32 {
    static constexpr bool PERM = false, AFTER_DRAIN = false;
    float* out; const float* res; int ldc; float alpha; const f32x2* stats; const float* gam; const float* bet;
    __device__ __forceinline__ void operator()(const f32x4 (&acc)[2][2][4][2], const Unit& u, int wr, int wc, int fr, int fq) const {
        const int row0 = u.pm * BM + wr * 64 + fr, col0 = u.pn * BM + wc * 32 + 4 * fq;
#pragma unroll
        for (int ai = 0; ai < 2; ++ai)
#pragma unroll
            for (int m = 0; m < 4; ++m) { const int row = row0 + ai * HALF + m * 16; const size_t off = (size_t)row * ldc + col0;
                f32x2 st = {0.f, 1.f}; if (stats) st = stats[row];
#pragma unroll
                for (int bj = 0; bj < 2; ++bj)
#pragma unroll
                    for (int n = 0; n < 2; ++n) { f32x4 v = acc[ai][bj][m][n];
                        if (res) { f32x4 r = *(const f32x4*)(res + off + bj * HALF + n * 16);
                            if (stats) { const f32x4 g4 = *(const f32x4*)(gam + col0 + bj * HALF + n * 16), b4 = *(const f32x4*)(bet + col0 + bj * HALF + n * 16); r = (r - st.x) * st.y * g4 + b4; }
                            v = v + r * alpha; }
                        *(f32x4*)(out + off + bj * HALF + n * 16) = v; } }
    }
};

struct EpiPair {
    static constexpr bool PERM = true, AFTER_DRAIN = false;
    int mode; bf16_t* D0; bf16_t* D1; const float* cosT; const float* sinT;
    __device__ __forceinline__ void operator()(const f32x4 (&acc)[2][2][4][2], const Unit& u, int wr, int wc, int fr, int fq) const {
        const int g = 4 * u.pn + wc; bf16_t* base; int pitch, col; bool rope;
        if (mode == 0) { base = D0; pitch = 1536; col = 64 * g; rope = (g % 3) == 2; }
        else if (mode == 1) { if (wc < 2) { base = D0; pitch = 1536; col = u.pn * 192 + 64 * wc; } else { base = D1; pitch = 1024; col = u.pn * 128 + 64 * (wc - 2); } rope = false; }
        else { base = D0; pitch = 3072; col = 64 * g; rope = (u.pn < 4) || (u.pn >= 8); }
        const int row0 = u.pm * BM + wr * 64 + fr;
#pragma unroll
        for (int ai = 0; ai < 2; ++ai)
#pragma unroll
            for (int m = 0; m < 4; ++m) { const int row = row0 + ai * HALF + m * 16;
                f32x4 v00 = acc[ai][0][m][0], v01 = acc[ai][0][m][1], v10 = acc[ai][1][m][0], v11 = acc[ai][1][m][1];
                if (rope) { const int pos = row & 4095; const float* cp = cosT + pos * 32 + 8 * fq; const float* sp = sinT + pos * 32 + 8 * fq;
                    const f32x4 c0 = *(const f32x4*)cp, c1 = *(const f32x4*)(cp + 4), s0 = *(const f32x4*)sp, s1 = *(const f32x4*)(sp + 4);
                    const f32x4 a0 = v00 * c0 - v10 * s0, a1 = v01 * c1 - v11 * s1, b0 = v10 * c0 + v00 * s0, b1 = v11 * c1 + v01 * s1;
                    v00 = a0; v01 = a1; v10 = b0; v11 = b1; }
                bf16_t* rp = base + (size_t)row * pitch + col + 8 * fq;
                *(u32x4*)rp = pack8(v00, v01); *(u32x4*)(rp + 32) = pack8(v10, v11); }
    }
};

struct EpiSwiglu {
    static constexpr bool PERM = true, AFTER_DRAIN = false;
    bf16_t* O; int ldc;
    __device__ __forceinline__ static f32x4 act(f32x4 g, f32x4 u) { f32x4 r;
#pragma unroll
        for (int j = 0; j < 4; ++j) { const float e = __builtin_amdgcn_exp2f(g[j] * -1.4426950408889634f); r[j] = g[j] * __builtin_amdgcn_rcpf(1.0f + e) * u[j]; }
        return r; }
    __device__ __forceinline__ void operator()(const f32x4 (&acc)[2][2][4][2], const Unit& u, int wr, int wc, int fr, int fq) const {
        const int row0 = u.pm * BM + wr * 64 + fr, col0 = u.pn * HALF + wc * 32 + 8 * fq;
#pragma unroll
        for (int ai = 0; ai < 2; ++ai)
#pragma unroll
            for (int m = 0; m < 4; ++m) { bf16_t* rp = O + (size_t)(row0 + ai * HALF + m * 16) * ldc + col0;
                *(u32x4*)rp = pack8(act(acc[ai][0][m][0], acc[ai][1][m][0]), act(acc[ai][0][m][1], acc[ai][1][m][1])); }
    }
};

template <class Epi, class Sched, bool ALIGN_EPI = false, bool SP2 = false>
__device__ __forceinline__ void gemm_phase(PG8_LAS unsigned char* lds, const Gemm g, const Sched& S, const Epi& E, const int tid_in) {
    int tid_ = tid_in; asm volatile("" : "+v"(tid_));
    const int tid = tid_, wid = __builtin_amdgcn_readfirstlane(tid >> 6), lane = tid & 63, wr = wid >> 2, wc = wid & 3, fr = lane & 15, fq = lane >> 4;
    const int K = g.K, nt = K / BK;
    unsigned voffA[2], voffB[2];
#pragma unroll
    for (int i = 0; i < 2; ++i) { int R, C; stage_rc(tid * 16 + i * 8192, R, C); const int Rb = Epi::PERM ? ((R & ~31) + perm32(R & 31)) : R;
        voffA[i] = (unsigned)(R * K + C) * 2u; voffB[i] = (unsigned)(Rb * K + C) * 2u; }
    const size_t kstep = (size_t)(BK * 2);
    const size_t hstep = (size_t)HALF * K * 2;
    const size_t tstep = 2 * hstep;
    const unsigned ldsw = (unsigned)wid * 1024u;
    const int aoff = lds_byte(wr * 64 + fr, fq * 8), boff = lds_byte(wc * 32 + fr, fq * 8);
#define PG8_SA(b, h) (((b) * 2 + (h)) * HTB)
#define PG8_SB(b, h) ((4 + (b) * 2 + (h)) * HTB)
#define PG8_STAGE(bufoff, gbase, voff) do { _Pragma("unroll") for (int _i = 0; _i < 2; ++_i) \
        __builtin_amdgcn_global_load_lds((const unsigned*)((const char*)(gbase) + (voff)[_i]), (PG8_LAS unsigned*)(lds + (bufoff) + ldsw + _i * 8192), 16, 0, 0); } while (0)
#define PG8_LDA(dst, b, h) do { _Pragma("unroll") for (int m = 0; m < 4; ++m) _Pragma("unroll") for (int k = 0; k < 2; ++k) dst[m][k] = *(const PG8_LAS bf16x8*)(lds + PG8_SA(b, h) + aoff + m * 2048 + k * 1024); } while (0)
#define PG8_LDB(dst, b, h) do { _Pragma("unroll") for (int n = 0; n < 2; ++n) _Pragma("unroll") for (int k = 0; k < 2; ++k) dst[n][k] = *(const PG8_LAS bf16x8*)(lds + PG8_SB(b, h) + boff + n * 2048 + k * 1024); } while (0)
#define PG8_MMA(ai, bj, At, Bt) do { __builtin_amdgcn_s_setprio(1); _Pragma("unroll") for (int m = 0; m < 4; ++m) _Pragma("unroll") for (int n = 0; n < 2; ++n) _Pragma("unroll") for (int k = 0; k < 2; ++k) \
        acc[ai][bj][m][n] = __builtin_amdgcn_mfma_f32_16x16x32_bf16(Bt[n][k], At[m][k], acc[ai][bj][m][n], 0, 0, 0); __builtin_amdgcn_s_setprio(0); } while (0)
#define PG8_WAIT_V(n) asm volatile("s_waitcnt vmcnt(" #n ")" ::: "memory")
#define PG8_WAIT_L(n) asm volatile("s_waitcnt lgkmcnt(" #n ")" ::: "memory")
#define PG8_BAR __builtin_amdgcn_s_barrier()
#define PG8_SCHED __builtin_amdgcn_sched_barrier(0)
    Unit cur, nxt; int ui = 0;
    if (!S.next(0, cur)) return;
    f32x4 acc[2][2][4][2];
#pragma unroll
    for (int a = 0; a < 2; ++a)
#pragma unroll
        for (int b = 0; b < 2; ++b)
#pragma unroll
            for (int m = 0; m < 4; ++m)
#pragma unroll
                for (int n = 0; n < 2; ++n) acc[a][b][m][n] = (f32x4){0.f, 0.f, 0.f, 0.f};
    bf16x8 At[4][2], B0[2][2], B1[2][2];
    const char* cA = (const char*)g.A + (size_t)cur.pm * tstep; const char* cB = (const char*)g.Bt + (size_t)cur.pn * tstep;
    S.a_ready(cur);
    if constexpr (SP2) {
        PG8_STAGE(PG8_SB(0, 0), cB, voffB); PG8_STAGE(PG8_SB(0, 1), cB + hstep, voffB); PG8_STAGE(PG8_SA(0, 0), cA, voffA); PG8_STAGE(PG8_SA(0, 1), cA + hstep, voffA);
        if (wr == 1) PG8_BAR;
        PG8_WAIT_V(2); PG8_BAR;
        PG8_STAGE(PG8_SB(1, 0), cB + kstep, voffB); PG8_STAGE(PG8_SA(1, 0), cA + kstep, voffA); PG8_STAGE(PG8_SB(1, 1), cB + hstep + kstep, voffB);
        PG8_WAIT_V(6); PG8_BAR;
    } else {
        PG8_STAGE(PG8_SB(0, 0), cB, voffB); PG8_STAGE(PG8_SA(0, 0), cA, voffA); PG8_STAGE(PG8_SB(0, 1), cB + hstep, voffB); PG8_STAGE(PG8_SA(0, 1), cA + hstep, voffA);
        if (wr == 1) PG8_BAR;
        PG8_WAIT_V(4); PG8_BAR;
        PG8_STAGE(PG8_SB(1, 0), cB + kstep, voffB); PG8_STAGE(PG8_SA(1, 0), cA + kstep, voffA); PG8_STAGE(PG8_SB(1, 1), cB + hstep + kstep, voffB);
        PG8_WAIT_V(6); PG8_BAR;
    }
    for (;;) {
        const bool has_next = S.next(ui + 1, nxt);
        const char* nA = has_next ? (const char*)g.A + (size_t)nxt.pm * tstep : cA; const char* nB = has_next ? (const char*)g.Bt + (size_t)nxt.pn * tstep : cB;
        for (int t = 0; t < nt; t += 2) {
            const bool last = (t == nt - 2);
            const char* a1 = cA + (size_t)(t + 1) * kstep;
            const char* a2 = last ? nA : cA + (size_t)(t + 2) * kstep; const char* b2 = last ? nB : cB + (size_t)(t + 2) * kstep;
            const char* a3 = a2 + kstep; const char* b3 = b2 + kstep;
            if (last && has_next) S.a_ready(nxt);
            if constexpr (SP2) {
            PG8_LDB(B0, 0, 0); PG8_LDB(B1, 0, 1); PG8_SCHED; PG8_LDA(At, 0, 0); PG8_STAGE(PG8_SA(1, 1), a1 + hstep, voffA);
            PG8_WAIT_V(8); PG8_WAIT_L(0); PG8_BAR; PG8_MMA(0, 0, At, B0); PG8_MMA(0, 1, At, B1); PG8_BAR; PG8_SCHED;
            PG8_LDA(At, 0, 1); PG8_STAGE(PG8_SB(0, 0), b2, voffB); PG8_STAGE(PG8_SB(0, 1), b2 + hstep, voffB); PG8_STAGE(PG8_SA(0, 0), a2, voffA);
            PG8_WAIT_V(8); PG8_WAIT_L(0); PG8_BAR; PG8_MMA(1, 0, At, B0); PG8_MMA(1, 1, At, B1); PG8_BAR; PG8_SCHED;
            PG8_LDB(B0, 1, 0); PG8_LDB(B1, 1, 1); PG8_SCHED; PG8_LDA(At, 1, 0); PG8_STAGE(PG8_SA(0, 1), a2 + hstep, voffA);
            PG8_WAIT_V(8); PG8_WAIT_L(0); PG8_BAR; PG8_MMA(0, 0, At, B0); PG8_MMA(0, 1, At, B1); PG8_BAR; PG8_SCHED;
            PG8_LDA(At, 1, 1); PG8_STAGE(PG8_SB(1, 0), b3, voffB); PG8_STAGE(PG8_SB(1, 1), b3 + hstep, voffB); PG8_STAGE(PG8_SA(1, 0), a3, voffA);
            PG8_WAIT_V(8); PG8_WAIT_L(0); PG8_BAR; PG8_MMA(1, 0, At, B0); PG8_MMA(1, 1, At, B1); PG8_BAR; PG8_SCHED;
            } else {
            PG8_LDB(B0, 0, 0); PG8_SCHED; PG8_LDA(At, 0, 0); PG8_STAGE(PG8_SA(1, 1), a1 + hstep, voffA);
            PG8_WAIT_L(8); PG8_BAR; PG8_WAIT_L(0); PG8_MMA(0, 0, At, B0); PG8_BAR; PG8_SCHED;
            PG8_LDB(B1, 0, 1); PG8_STAGE(PG8_SB(0, 0), b2, voffB);
            PG8_BAR; PG8_WAIT_L(0); PG8_MMA(0, 1, At, B1); PG8_BAR;
            PG8_LDA(At, 0, 1); PG8_STAGE(PG8_SA(0, 0), a2, voffA);
            PG8_BAR; PG8_WAIT_L(0); PG8_MMA(1, 0, At, B0); PG8_BAR; PG8_SCHED;
            PG8_STAGE(PG8_SB(0, 1), b2 + hstep, voffB);
            PG8_WAIT_V(6); PG8_BAR; PG8_MMA(1, 1, At, B1); PG8_BAR;
            PG8_LDB(B0, 1, 0); PG8_SCHED; PG8_LDA(At, 1, 0); PG8_STAGE(PG8_SA(0, 1), a2 + hstep, voffA);
            PG8_WAIT_L(8); PG8_BAR; PG8_WAIT_L(0); PG8_MMA(0, 0, At, B0); PG8_BAR; PG8_SCHED;
            PG8_LDB(B1, 1, 1); PG8_STAGE(PG8_SB(1, 0), b3, voffB);
            PG8_BAR; PG8_WAIT_L(0); PG8_MMA(0, 1, At, B1); PG8_BAR;
            PG8_LDA(At, 1, 1); PG8_STAGE(PG8_SA(1, 0), a3, voffA);
            PG8_BAR; PG8_WAIT_L(0); PG8_MMA(1, 0, At, B0); PG8_BAR; PG8_SCHED;
            PG8_STAGE(PG8_SB(1, 1), b3 + hstep, voffB);
            PG8_WAIT_V(6); PG8_BAR; PG8_MMA(1, 1, At, B1); PG8_BAR;
            }
        }
        if constexpr (ALIGN_EPI) { if (wr == 0) PG8_BAR; }
        if constexpr (!Epi::AFTER_DRAIN) { E(acc, cur, wr, wc, fr, fq); S.done(cur); }
        if (!has_next) break;
#pragma unroll
        for (int a = 0; a < 2; ++a)
#pragma unroll
            for (int b = 0; b < 2; ++b)
#pragma unroll
                for (int m = 0; m < 4; ++m)
#pragma unroll
                    for (int n = 0; n < 2; ++n) acc[a][b][m][n] = (f32x4){0.f, 0.f, 0.f, 0.f};
        cur = nxt; cA = nA; cB = nB; ++ui;
        if constexpr (ALIGN_EPI) { if (wr == 1) PG8_BAR; }
    }
    PG8_WAIT_V(0);
    if constexpr (!ALIGN_EPI) { if (wr == 0) PG8_BAR; }
    PG8_BAR;
    if constexpr (Epi::AFTER_DRAIN) { E.fused(acc, cur, wr, wc, fr, fq, lds, wid, lane); S.done(cur); }
#undef PG8_SA
#undef PG8_SB
#undef PG8_STAGE
#undef PG8_LDA
#undef PG8_LDB
#undef PG8_MMA
#undef PG8_WAIT_V
#undef PG8_WAIT_L
#undef PG8_BAR
#undef PG8_SCHED
}
}
namespace att {
typedef unsigned short bf16_t;
typedef short bf16x8 __attribute__((ext_vector_type(8)));
typedef short s16x4 __attribute__((ext_vector_type(4)));
typedef float f32x16 __attribute__((ext_vector_type(16)));
typedef unsigned u32x4 __attribute__((ext_vector_type(4)));
#define ALAS __attribute__((address_space(3)))
#define SBAR() __builtin_amdgcn_sched_barrier(0)
constexpr int SHM_V = 64 * 128 * 2;
constexpr int LDS_K0 = 2 * SHM_V;
__device__ __forceinline__ int v_st(int k, int c) { const int kk = (k & ~0xC) | ((k & 4) << 1) | ((k & 8) >> 1); return ((kk >> 3) * 4 + (c >> 5)) * 512 + ((kk & 7) * 32 + (c & 31)) * 2; }
__device__ __forceinline__ int v_rd_base(int lane) { return ((lane & 3) << 3) | (((lane >> 2) & 3) << 6) | (((lane >> 4) & 1) << 5) | (((lane >> 5) & 1) << 8); }
constexpr int v_rd_off(int d0, int ks, int half) { return d0 * 512 + ks * 4096 + half * 2048; }
__device__ __forceinline__ int crow(int r, int hi) { return (r & 3) + 8 * (r >> 2) + 4 * hi; }
__device__ __forceinline__ unsigned cvtpk(float lo, float hi) { unsigned r; asm volatile("v_cvt_pk_bf16_f32 %0, %1, %2" : "=v"(r) : "v"(lo), "v"(hi)); return r; }
__device__ __forceinline__ void mask_half(f32x16& p, int dq) {
    const float NEG = -__builtin_inff();
#pragma unroll
    for (int r = 0; r < 16; ++r) { const int c = (r & 3) + 8 * (r >> 2); p[r] = (dq - c < 0) ? NEG : p[r]; }
}
template <int NEXPB>
__device__ __forceinline__ void sm_partial(f32x16& p, float& m_reg, float& alpha, const float C2) {
    float pmax = fmaxf(fmaxf(p[0], p[1]), p[2]);
#pragma unroll
    for (int r = 3; r < 15; r += 2) pmax = fmaxf(fmaxf(pmax, p[r]), p[r + 1]);
    pmax = fmaxf(pmax, p[15]);
    { auto rr = __builtin_amdgcn_permlane32_swap(__float_as_uint(pmax), __float_as_uint(pmax), false, false); pmax = fmaxf(__uint_as_float(rr[0]), __uint_as_float(rr[1])); }
    const bool need = __any((pmax - m_reg) * C2 > 11.5f);
    const float mn = need ? fmaxf(m_reg, pmax) : m_reg;
    alpha = __builtin_amdgcn_exp2f((m_reg - mn) * C2); m_reg = mn;
    const float mnL = -mn * C2;
#pragma unroll
    for (int r = 0; r < 16; ++r) p[r] = fmaf(p[r], C2, mnL);
#pragma unroll
    for (int r = 0; r < NEXPB; ++r) p[r] = __builtin_amdgcn_exp2f(p[r]);
}
template <int NEXPB>
__device__ __forceinline__ void sm_pack(f32x16& p, float alpha, float& l_reg, bf16x8& pa0, bf16x8& pa1) {
#pragma unroll
    for (int r = NEXPB; r < 16; ++r) p[r] = __builtin_amdgcn_exp2f(p[r]);
    float ps0 = p[0] + p[1], ps1 = p[2] + p[3];
#pragma unroll
    for (int r = 4; r < 16; r += 4) { ps0 += p[r] + p[r + 1]; ps1 += p[r + 2] + p[r + 3]; }
    float ps = ps0 + ps1;
    { auto rr = __builtin_amdgcn_permlane32_swap(__float_as_uint(ps), __float_as_uint(ps), false, false); ps = __uint_as_float(rr[0]) + __uint_as_float(rr[1]); }
    l_reg = l_reg * alpha + ps;
#define PK4(P, B_, OUT) do { unsigned a0 = cvtpk(P[B_+0], P[B_+1]), a1 = cvtpk(P[B_+2], P[B_+3]);                          \
        unsigned b0 = cvtpk(P[B_+4], P[B_+5]), b1 = cvtpk(P[B_+6], P[B_+7]);                                             \
        auto r0 = __builtin_amdgcn_permlane32_swap(a0, b0, false, false); auto r1 = __builtin_amdgcn_permlane32_swap(a1, b1, false, false); \
        u32x4 w = {r0[0], r1[0], r0[1], r1[1]}; OUT = __builtin_bit_cast(bf16x8, w); } while (0)
    PK4(p, 0, pa0); PK4(p, 8, pa1);
#undef PK4
}
template <int DQK>
__device__ __forceinline__ void qkt_half(f32x16& p, const ALAS char* kp, const bf16x8* qr) {
    constexpr int ND = DQK / 16;
    p = f32x16{};
#pragma unroll
    for (int d0 = 0; d0 < ND; ++d0) { const bf16x8 b = *(const ALAS bf16x8*)(kp + d0 * 32); p = __builtin_amdgcn_mfma_f32_32x32x16_bf16(b, qr[d0], p, 0, 0, 0); }
}
__device__ __forceinline__ void pv_half(f32x16* o, int vb, bf16x8 pa0, bf16x8 pa1) {
#define TRRD(dst, off) asm volatile("ds_read_b64_tr_b16 %0, %1 offset:%2" : "=&v"(dst) : "v"(vb), "i"(off) : "memory")
#define PV_KS(ks, pa) do { s16x4 l0, l1, l2, l3, h0, h1, h2, h3; constexpr int b_ = (ks) * 4096; \
        TRRD(l0, b_); TRRD(h0, b_ + 2048); TRRD(l1, b_ + 512); TRRD(h1, b_ + 512 + 2048); TRRD(l2, b_ + 1024); TRRD(h2, b_ + 1024 + 2048); TRRD(l3, b_ + 1536); TRRD(h3, b_ + 1536 + 2048); \
        asm volatile("s_waitcnt lgkmcnt(0)" : "+v"(l0), "+v"(h0), "+v"(l1), "+v"(h1), "+v"(l2), "+v"(h2), "+v"(l3), "+v"(h3) :: "memory");     \
        o[0] = __builtin_amdgcn_mfma_f32_32x32x16_bf16(pa, (bf16x8){l0[0], l0[1], l0[2], l0[3], h0[0], h0[1], h0[2], h0[3]}, o[0], 0, 0, 0);   \
        o[1] = __builtin_amdgcn_mfma_f32_32x32x16_bf16(pa, (bf16x8){l1[0], l1[1], l1[2], l1[3], h1[0], h1[1], h1[2], h1[3]}, o[1], 0, 0, 0);   \
        o[2] = __builtin_amdgcn_mfma_f32_32x32x16_bf16(pa, (bf16x8){l2[0], l2[1], l2[2], l2[3], h2[0], h2[1], h2[2], h2[3]}, o[2], 0, 0, 0);   \
        o[3] = __builtin_amdgcn_mfma_f32_32x32x16_bf16(pa, (bf16x8){l3[0], l3[1], l3[2], l3[3], h3[0], h3[1], h3[2], h3[3]}, o[3], 0, 0, 0); } while (0)
    PV_KS(0, pa0); PV_KS(1, pa1);
#undef PV_KS
#undef TRRD
}

template <int DQK> constexpr int lds_bytes() { return 3 * SHM_V + 2 * 64 * (DQK * 2 + 16) + 8 * 256; }

template <int DQK, int NEXPB, int PD>
__device__ __forceinline__ void attn_unit(const bf16_t* __restrict__ Q, int qp, const bf16_t* __restrict__ K, int kp, const bf16_t* __restrict__ V, int vp, bf16_t* __restrict__ O, int op, int qb, const float C2, char* lds, const int tid_in) {
    constexpr int RP = DQK * 2 + 16, SHM_K = 64 * RP, ND = DQK / 16, CH = DQK / 8, NKC = (64 * CH) / 512;
    int tid_ = tid_in; asm volatile("" : "+v"(tid_));
    const int tid = tid_, wid = __builtin_amdgcn_readfirstlane(tid >> 6), lane = tid & 63, r32 = lane & 31, hi = lane >> 5;
    const int q0 = qb * 256 + wid * 32, NT = 4 * (qb + 1);
    ALAS char* V_lds = (ALAS char*)lds; ALAS char* K_lds = V_lds + 3 * SHM_V;
    ALAS float* wsf = (ALAS float*)(K_lds + 2 * SHM_K) + wid * 64; ALAS float* li_l = wsf; ALAS float* al_l = wsf + 32;
    bf16x8 qr[ND];
    { const char* qbase = (const char*)Q + (size_t)q0 * qp * 2; const unsigned qo = (unsigned)(r32 * qp + hi * 8) * 2u;
#pragma unroll
      for (int d0 = 0; d0 < ND; ++d0) qr[d0] = *(const bf16x8*)(qbase + qo + d0 * 32); }
    unsigned koff[NKC]; int klds[NKC];
#pragma unroll
    for (int i = 0; i < NKC; ++i) { const int id = tid + 512 * i, row = id / CH, c = id % CH; koff[i] = (unsigned)(row * kp + c * 8) * 2u; klds[i] = row * RP + c * 16; }
    const int sr = tid >> 4, sc = (tid & 15) * 8, vst0 = v_st(sr, sc), vst1 = v_st(32 + sr, sc);
    const unsigned voff0 = (unsigned)(sr * vp + sc) * 2u, voff1 = (unsigned)((32 + sr) * vp + sc) * 2u;
    const int vb0 = (int)(uintptr_t)lds + v_rd_base(lane);
    const ALAS char* krd = K_lds + r32 * RP + hi * 16;
    bf16x8 stkA[NKC], stvA0, stvA1, stkB[NKC], stvB0, stvB1;
#define LOADT(S, t) do { const char* kt_ = (const char*)K + (size_t)(t) * 64 * kp * 2; const char* vt_ = (const char*)V + (size_t)(t) * 64 * vp * 2; \
        _Pragma("unroll") for (int i = 0; i < NKC; ++i) stk##S[i] = *(const bf16x8*)(kt_ + koff[i]); \
        stv##S##0 = *(const bf16x8*)(vt_ + voff0); stv##S##1 = *(const bf16x8*)(vt_ + voff1); } while (0)
#define WRITET(S, kofs, vofs) do { _Pragma("unroll") for (int i = 0; i < NKC; ++i) *(ALAS bf16x8*)(K_lds + (kofs) + klds[i]) = stk##S[i]; \
        *(ALAS bf16x8*)(V_lds + (vofs) + vst0) = stv##S##0; *(ALAS bf16x8*)(V_lds + (vofs) + vst1) = stv##S##1; } while (0)
#define RESC(al) do { if (__any((al) < 1.f)) { if (hi == 0) al_l[r32] = (al); asm volatile("s_waitcnt lgkmcnt(0)" ::: "memory"); \
        _Pragma("unroll") for (int d_ = 0; d_ < 4; ++d_) _Pragma("unroll") for (int r = 0; r < 16; ++r) o[d_][r] *= al_l[crow(r, hi)]; } } while (0)
    float m_reg = -1e30f, l_reg = 0.f; f32x16 o[4] = {};
    f32x16 pA, pB; float alA = 1.f, alB = 1.f; bf16x8 pa0, pa1;
    LOADT(A, 0); WRITET(A, 0, 0); if (PD == 2) { LOADT(B, 1); } __syncthreads();
    int kofs = 0, vcur = 0, vprev = 0;
#define STEP_T(t, FIRST, MASK, SL, SW) do { const int dq0_ = q0 + r32 - 4 * hi - (t) * 64; \
        const int vnext_ = (vcur == 2 * SHM_V) ? 0 : vcur + SHM_V; \
        if (PD == 2) { if ((t) + 2 < NT) { LOADT(SL, (t) + 2); } } else { if ((t) + 1 < NT) { LOADT(SW, (t) + 1); } } SBAR(); \
        if (!(FIRST)) sm_pack<NEXPB>(pB, alB, l_reg, pa0, pa1); \
        qkt_half<DQK>(pA, krd + kofs, qr); \
        SBAR(); \
        if (!(FIRST)) pv_half(o, vb0 + vprev + 8192, pa0, pa1); \
        if (MASK) mask_half(pA, dq0_); \
        sm_partial<NEXPB>(pA, m_reg, alA, C2); \
        SBAR(); if (!(FIRST)) RESC(alA); SBAR(); \
        sm_pack<NEXPB>(pA, alA, l_reg, pa0, pa1); \
        qkt_half<DQK>(pB, krd + kofs + 32 * RP, qr); \
        SBAR(); \
        pv_half(o, vb0 + vcur, pa0, pa1); \
        if (MASK) mask_half(pB, dq0_ - 32); \
        sm_partial<NEXPB>(pB, m_reg, alB, C2); \
        SBAR(); RESC(alB); SBAR(); \
        if ((t) + 1 < NT) { WRITET(SW, kofs ^ SHM_K, vnext_); } \
        vprev = vcur; vcur = vnext_; kofs ^= SHM_K; \
        asm volatile("s_waitcnt lgkmcnt(0)\n\ts_barrier" ::: "memory"); } while (0)
    if (PD == 1) {
        STEP_T(0, true, true, A, A);
        int t = 1;
        for (; t < NT - 4; ++t) STEP_T(t, false, false, A, A);
        for (; t < NT; ++t) STEP_T(t, false, true, A, A);
    } else {
    STEP_T(0, true, true, A, B);
    int t = 1;
    for (; t + 1 <= NT - 6; t += 2) { STEP_T(t, false, false, B, A); STEP_T(t + 1, false, false, A, B); }
    for (; t + 1 < NT; t += 2) { STEP_T(t, false, true, B, A); STEP_T(t + 1, false, true, A, B); }
    STEP_T(t, false, true, B, A);
    }
    sm_pack<NEXPB>(pB, alB, l_reg, pa0, pa1); SBAR();
    pv_half(o, vb0 + vprev + 8192, pa0, pa1);
#undef STEP_T
#undef RESC
#undef LOADT
#undef WRITET
    if (hi == 0) li_l[r32] = l_reg; asm volatile("s_waitcnt lgkmcnt(0)" ::: "memory");
    float rli[16];
#pragma unroll
    for (int r = 0; r < 16; ++r) rli[r] = __builtin_amdgcn_rcpf(li_l[crow(r, hi)]);
    __syncthreads();
    { ALAS char* stg = (ALAS char*)lds + wid * 8704 + (4 * hi) * 272 + r32 * 2;
#pragma unroll
      for (int r = 0; r < 16; ++r) { const int cr = (r & 3) + 8 * (r >> 2);
#pragma unroll
        for (int d0 = 0; d0 < 4; ++d0) *(ALAS unsigned short*)(stg + cr * 272 + d0 * 64) = (unsigned short)cvtpk(o[d0][r] * rli[r], 0.f); }
      asm volatile("s_waitcnt lgkmcnt(0)" ::: "memory");
      char* Ow = (char*)O + (size_t)(qb * 256 + wid * 32) * op * 2; const ALAS char* rd = (const ALAS char*)lds + wid * 8704;
#pragma unroll
      for (int i = 0; i < 8; ++i) { const int id = i * 64 + lane, row = id >> 4, c = id & 15;
          const u32x4 v = *(const ALAS u32x4*)(rd + row * 272 + c * 16); *(u32x4*)(Ow + ((size_t)row * op + c * 8) * 2) = v; } }
    __syncthreads();
}
template <int DQK, int NEXPB, int PD>
__device__ __forceinline__ void attn_unit_s(const bf16_t* __restrict__ Q, int qp, const bf16_t* __restrict__ K, int kp, const bf16_t* __restrict__ V, int vp, bf16_t* __restrict__ O, int op, int qb, const float C2, char* lds, const int tid_in) {
    constexpr int RP = DQK * 2 + 16, SHM_K = 64 * RP, ND = DQK / 16, CH = DQK / 8, NKC = (64 * CH) / 512;
    static_assert(ND == 4 || ND == 12, "DQK is 64 or 192");
    int tid_ = tid_in; asm volatile("" : "+v"(tid_));
    const int tid = tid_, wid = __builtin_amdgcn_readfirstlane(tid >> 6), lane = tid & 63, r32 = lane & 31, hi = lane >> 5;
    const int q0 = qb * 256 + wid * 32, NT = 4 * (qb + 1);
    ALAS char* V_lds = (ALAS char*)lds; ALAS char* K_lds = V_lds + 3 * SHM_V;
    ALAS float* wsf = (ALAS float*)(K_lds + 2 * SHM_K) + wid * 64; ALAS float* li_l = wsf; ALAS float* al_l = wsf + 32;
    bf16x8 qr[ND];
    { const char* qbase = (const char*)Q + (size_t)q0 * qp * 2; const unsigned qo = (unsigned)(r32 * qp + hi * 8) * 2u;
#pragma unroll
      for (int d0 = 0; d0 < ND; ++d0) qr[d0] = *(const bf16x8*)(qbase + qo + d0 * 32); }
    unsigned koff[NKC]; int klds[NKC];
#pragma unroll
    for (int i = 0; i < NKC; ++i) { const int id = tid + 512 * i, row = id / CH, c = id % CH; koff[i] = (unsigned)(row * kp + c * 8) * 2u; klds[i] = row * RP + c * 16; }
    const int sr = tid >> 4, sc = (tid & 15) * 8, vst0 = v_st(sr, sc), vst1 = v_st(32 + sr, sc);
    const unsigned voff0 = (unsigned)(sr * vp + sc) * 2u, voff1 = (unsigned)((32 + sr) * vp + sc) * 2u;
    const int vb0 = (int)(uintptr_t)lds + v_rd_base(lane);
    const ALAS char* krd = K_lds + r32 * RP + hi * 16;
    bf16x8 stkA[NKC], stvA0, stvA1, stkB[NKC], stvB0, stvB1;
#define LOADT(S, t) do { const char* kt_ = (const char*)K + (size_t)(t) * 64 * kp * 2; const char* vt_ = (const char*)V + (size_t)(t) * 64 * vp * 2; \
        _Pragma("unroll") for (int i = 0; i < NKC; ++i) stk##S[i] = *(const bf16x8*)(kt_ + koff[i]); \
        stv##S##0 = *(const bf16x8*)(vt_ + voff0); stv##S##1 = *(const bf16x8*)(vt_ + voff1); } while (0)
#define WRITET(S, kofs, vofs) do { _Pragma("unroll") for (int i = 0; i < NKC; ++i) *(ALAS bf16x8*)(K_lds + (kofs) + klds[i]) = stk##S[i]; \
        *(ALAS bf16x8*)(V_lds + (vofs) + vst0) = stv##S##0; *(ALAS bf16x8*)(V_lds + (vofs) + vst1) = stv##S##1; } while (0)
#define RESC(al) do { if (__any((al) < 1.f)) { if (hi == 0) al_l[r32] = (al); asm volatile("s_waitcnt lgkmcnt(0)" ::: "memory"); \
        _Pragma("unroll") for (int d_ = 0; d_ < 4; ++d_) _Pragma("unroll") for (int r = 0; r < 16; ++r) o[d_][r] *= al_l[crow(r, hi)]; } } while (0)
#define TRRD(dst, vb, off) asm volatile("ds_read_b64_tr_b16 %0, %1 offset:%2" : "=&v"(dst) : "v"(vb), "i"(off) : "memory")
#define VREAD(S, vb, ks) do { TRRD(S##l0, vb, (ks) * 4096); TRRD(S##h0, vb, (ks) * 4096 + 2048); TRRD(S##l1, vb, (ks) * 4096 + 512); TRRD(S##h1, vb, (ks) * 4096 + 512 + 2048); \
        TRRD(S##l2, vb, (ks) * 4096 + 1024); TRRD(S##h2, vb, (ks) * 4096 + 1024 + 2048); TRRD(S##l3, vb, (ks) * 4096 + 1536); TRRD(S##h3, vb, (ks) * 4096 + 1536 + 2048); } while (0)
#define VWAIT(S) asm volatile("s_waitcnt lgkmcnt(0)" : "+v"(S##l0), "+v"(S##h0), "+v"(S##l1), "+v"(S##h1), "+v"(S##l2), "+v"(S##h2), "+v"(S##l3), "+v"(S##h3) :: "memory")
#define VFR(S, d) (bf16x8){S##l##d[0], S##l##d[1], S##l##d[2], S##l##d[3], S##h##d[0], S##h##d[1], S##h##d[2], S##h##d[3]}
#define PK4(P, B_, OUT) do { unsigned a0_ = cvtpk(P[B_+0], P[B_+1]), a1_ = cvtpk(P[B_+2], P[B_+3]);                          \
        unsigned b0_ = cvtpk(P[B_+4], P[B_+5]), b1_ = cvtpk(P[B_+6], P[B_+7]);                                             \
        auto r0_ = __builtin_amdgcn_permlane32_swap(a0_, b0_, false, false); auto r1_ = __builtin_amdgcn_permlane32_swap(a1_, b1_, false, false); \
        u32x4 w_ = {r0_[0], r1_[0], r0_[1], r1_[1]}; OUT = __builtin_bit_cast(bf16x8, w_); } while (0)
    float m_reg = -1e30f, l_reg = 0.f; f32x16 o[4] = {};
    f32x16 pA, pB; float alA = 1.f, alB = 1.f; bf16x8 pa0, pa1;
    s16x4 Gl0, Gl1, Gl2, Gl3, Gh0, Gh1, Gh2, Gh3, Hl0, Hl1, Hl2, Hl3, Hh0, Hh1, Hh2, Hh3;
#define STAGE_A(X, Y, alY, kptr, vbp, PACK) do { \
        const ALAS char* kp_ = (kptr); const int vbp_ = (vbp); \
        if (PACK) VREAD(G, vbp_, 0); \
        bf16x8 kf[ND]; \
        _Pragma("unroll") for (int d0 = 0; d0 < (ND == 4 ? 4 : 6); ++d0) kf[d0] = *(const ALAS bf16x8*)(kp_ + d0 * 32); \
        SBAR(); \
        float psa_ = 0.f, psb_ = 0.f; \
        _Pragma("unroll") for (int i = 0; i < ND; ++i) { \
            if (i == 0) X = __builtin_amdgcn_mfma_f32_32x32x16_bf16(kf[0], qr[0], f32x16{}, 0, 0, 0); \
            else X = __builtin_amdgcn_mfma_f32_32x32x16_bf16(kf[i], qr[i], X, 0, 0, 0); \
            if (ND == 12 && i == 2) { _Pragma("unroll") for (int d0 = 6; d0 < 12; ++d0) kf[d0] = *(const ALAS bf16x8*)(kp_ + d0 * 32); } \
            if (PACK) { \
                if (ND == 4) { _Pragma("unroll") for (int r = 4 * i; r < 4 * i + 4; ++r) if (r >= NEXPB) Y[r] = __builtin_amdgcn_exp2f(Y[r]); \
                    psa_ += Y[4 * i] + Y[4 * i + 1]; psb_ += Y[4 * i + 2] + Y[4 * i + 3]; \
                    if (i == 1) PK4(Y, 0, pa0); if (i == 3) PK4(Y, 8, pa1); } \
                else { if (i == 0) { psa_ = Y[0] + Y[1]; psb_ = Y[2] + Y[3]; } \
                    Y[4 + i] = __builtin_amdgcn_exp2f(Y[4 + i]); if (i & 1) psb_ += Y[4 + i]; else psa_ += Y[4 + i]; \
                    if (i == 4) PK4(Y, 0, pa0); } } \
            SBAR(); } \
        if (PACK) { if (ND == 12) PK4(Y, 8, pa1); \
            float ps_ = psa_ + psb_; { auto rr = __builtin_amdgcn_permlane32_swap(__float_as_uint(ps_), __float_as_uint(ps_), false, false); ps_ = __uint_as_float(rr[0]) + __uint_as_float(rr[1]); } \
            l_reg = l_reg * (alY) + ps_; } \
        SBAR(); } while (0)
#define STAGE_B(X, alX, vbp, PV, MASK, dq) do { \
        const int vbp_ = (vbp); \
        if (PV) { VWAIT(G); VREAD(H, vbp_, 1); } \
        float pmax_ = 0.f, mnL_ = 0.f; \
        _Pragma("unroll") for (int i = 0; i < 8; ++i) { \
            if (PV) { if (i == 4) VWAIT(H); \
                if (i == 0) o[0] = __builtin_amdgcn_mfma_f32_32x32x16_bf16(pa0, VFR(G, 0), o[0], 0, 0, 0); \
                if (i == 1) o[1] = __builtin_amdgcn_mfma_f32_32x32x16_bf16(pa0, VFR(G, 1), o[1], 0, 0, 0); \
                if (i == 2) o[2] = __builtin_amdgcn_mfma_f32_32x32x16_bf16(pa0, VFR(G, 2), o[2], 0, 0, 0); \
                if (i == 3) o[3] = __builtin_amdgcn_mfma_f32_32x32x16_bf16(pa0, VFR(G, 3), o[3], 0, 0, 0); \
                if (i == 4) o[0] = __builtin_amdgcn_mfma_f32_32x32x16_bf16(pa1, VFR(H, 0), o[0], 0, 0, 0); \
                if (i == 5) o[1] = __builtin_amdgcn_mfma_f32_32x32x16_bf16(pa1, VFR(H, 1), o[1], 0, 0, 0); \
                if (i == 6) o[2] = __builtin_amdgcn_mfma_f32_32x32x16_bf16(pa1, VFR(H, 2), o[2], 0, 0, 0); \
                if (i == 7) o[3] = __builtin_amdgcn_mfma_f32_32x32x16_bf16(pa1, VFR(H, 3), o[3], 0, 0, 0); } \
            if (i == 0) { if (MASK) mask_half(X, (dq)); \
                pmax_ = fmaxf(fmaxf(X[0], X[1]), X[2]); \
                _Pragma("unroll") for (int r = 3; r < 15; r += 2) pmax_ = fmaxf(fmaxf(pmax_, X[r]), X[r + 1]); \
                pmax_ = fmaxf(pmax_, X[15]); } \
            if (i == 1) { { auto rr = __builtin_amdgcn_permlane32_swap(__float_as_uint(pmax_), __float_as_uint(pmax_), false, false); pmax_ = fmaxf(__uint_as_float(rr[0]), __uint_as_float(rr[1])); } \
                const bool need_ = __any((pmax_ - m_reg) * C2 > 11.5f); \
                const float mn_ = need_ ? fmaxf(m_reg, pmax_) : m_reg; \
                alX = __builtin_amdgcn_exp2f((m_reg - mn_) * C2); m_reg = mn_; mnL_ = -mn_ * C2; } \
            if (i == 2) { _Pragma("unroll") for (int r = 0; r < 8; ++r) X[r] = fmaf(X[r], C2, mnL_); asm volatile("" : "+v"(X)); } \
            if (i == 3) { _Pragma("unroll") for (int r = 8; r < 16; ++r) X[r] = fmaf(X[r], C2, mnL_); asm volatile("" : "+v"(X)); } \
            if (i >= 4) { _Pragma("unroll") for (int r = (i - 4) * (NEXPB / 4); r < (i - 3) * (NEXPB / 4); ++r) X[r] = __builtin_amdgcn_exp2f(X[r]); if (NEXPB > 0) asm volatile("" : "+v"(X)); } \
            SBAR(); } \
        } while (0)
    LOADT(A, 0); WRITET(A, 0, 0); if (PD == 2) { LOADT(B, 1); } __syncthreads();
    int kofs = 0, vcur = 0, vprev = 0;
#define STEP_T(t, FIRST, MASK, SL, SW) do { const int dq0_ = q0 + r32 - 4 * hi - (t) * 64; \
        const int vnext_ = (vcur == 2 * SHM_V) ? 0 : vcur + SHM_V; \
        if (PD == 2) { if ((t) + 2 < NT) { LOADT(SL, (t) + 2); } } else { if ((t) + 1 < NT) { LOADT(SW, (t) + 1); } } SBAR(); \
        STAGE_A(pA, pB, alB, krd + kofs, vb0 + vprev + 8192, !(FIRST)); \
        STAGE_B(pA, alA, vb0 + vprev + 8192, !(FIRST), MASK, dq0_); \
        if (!(FIRST)) RESC(alA); SBAR(); \
        STAGE_A(pB, pA, alA, krd + kofs + 32 * RP, vb0 + vcur, true); \
        STAGE_B(pB, alB, vb0 + vcur, true, MASK, dq0_ - 32); \
        RESC(alB); SBAR(); \
        if ((t) + 1 < NT) { WRITET(SW, kofs ^ SHM_K, vnext_); } \
        vprev = vcur; vcur = vnext_; kofs ^= SHM_K; \
        asm volatile("s_waitcnt lgkmcnt(0)\n\ts_barrier" ::: "memory"); } while (0)
    if (PD == 1) {
        STEP_T(0, true, true, A, A);
        int t = 1;
        for (; t < NT - 4; ++t) STEP_T(t, false, false, A, A);
        for (; t < NT; ++t) STEP_T(t, false, true, A, A);
    } else {
    STEP_T(0, true, true, A, B);
    int t = 1;
    for (; t + 1 <= NT - 6; t += 2) { STEP_T(t, false, false, B, A); STEP_T(t + 1, false, false, A, B); }
    for (; t + 1 < NT; t += 2) { STEP_T(t, false, true, B, A); STEP_T(t + 1, false, true, A, B); }
    STEP_T(t, false, true, B, A);
    }
    { VREAD(G, vb0 + vprev + 8192, 0); VREAD(H, vb0 + vprev + 8192, 1);
#pragma unroll
      for (int r = NEXPB; r < 16; ++r) pB[r] = __builtin_amdgcn_exp2f(pB[r]);
      float ps = 0.f;
#pragma unroll
      for (int r = 0; r < 16; ++r) ps += pB[r];
      { auto rr = __builtin_amdgcn_permlane32_swap(__float_as_uint(ps), __float_as_uint(ps), false, false); ps = __uint_as_float(rr[0]) + __uint_as_float(rr[1]); }
      l_reg = l_reg * alB + ps; PK4(pB, 0, pa0); PK4(pB, 8, pa1);
      VWAIT(G); VWAIT(H);
      o[0] = __builtin_amdgcn_mfma_f32_32x32x16_bf16(pa0, VFR(G, 0), o[0], 0, 0, 0); o[1] = __builtin_amdgcn_mfma_f32_32x32x16_bf16(pa0, VFR(G, 1), o[1], 0, 0, 0);
      o[2] = __builtin_amdgcn_mfma_f32_32x32x16_bf16(pa0, VFR(G, 2), o[2], 0, 0, 0); o[3] = __builtin_amdgcn_mfma_f32_32x32x16_bf16(pa0, VFR(G, 3), o[3], 0, 0, 0);
      o[0] = __builtin_amdgcn_mfma_f32_32x32x16_bf16(pa1, VFR(H, 0), o[0], 0, 0, 0); o[1] = __builtin_amdgcn_mfma_f32_32x32x16_bf16(pa1, VFR(H, 1), o[1], 0, 0, 0);
      o[2] = __builtin_amdgcn_mfma_f32_32x32x16_bf16(pa1, VFR(H, 2), o[2], 0, 0, 0); o[3] = __builtin_amdgcn_mfma_f32_32x32x16_bf16(pa1, VFR(H, 3), o[3], 0, 0, 0); }
#undef STEP_T
#undef STAGE_A
#undef STAGE_B
#undef PK4
#undef VFR
#undef VWAIT
#undef VREAD
#undef TRRD
#undef RESC
#undef LOADT
#undef WRITET
    if (hi == 0) li_l[r32] = l_reg; asm volatile("s_waitcnt lgkmcnt(0)" ::: "memory");
    float rli[16];
#pragma unroll
    for (int r = 0; r < 16; ++r) rli[r] = __builtin_amdgcn_rcpf(li_l[crow(r, hi)]);
    __syncthreads();
    { ALAS char* stg = (ALAS char*)lds + wid * 8704 + (4 * hi) * 272 + r32 * 2;
#pragma unroll
      for (int r = 0; r < 16; ++r) { const int cr = (r & 3) + 8 * (r >> 2);
#pragma unroll
        for (int d0 = 0; d0 < 4; ++d0) *(ALAS unsigned short*)(stg + cr * 272 + d0 * 64) = (unsigned short)cvtpk(o[d0][r] * rli[r], 0.f); }
      asm volatile("s_waitcnt lgkmcnt(0)" ::: "memory");
      char* Ow = (char*)O + (size_t)(qb * 256 + wid * 32) * op * 2; const ALAS char* rd = (const ALAS char*)lds + wid * 8704;
#pragma unroll
      for (int i = 0; i < 8; ++i) { const int id = i * 64 + lane, row = id >> 4, c = id & 15;
          const u32x4 v = *(const ALAS u32x4*)(rd + row * 272 + c * 16); *(u32x4*)(Ow + ((size_t)row * op + c * 8) * 2) = v; } }
    __syncthreads();
}
#undef SBAR
}

#define GAS __attribute__((address_space(1)))
#define LAS __attribute__((address_space(3)))
typedef unsigned short bf16;
typedef unsigned v4u __attribute__((ext_vector_type(4)));
typedef float f32x4 __attribute__((ext_vector_type(4)));
typedef short bf16x8 __attribute__((ext_vector_type(8)));
typedef GAS unsigned gu32;
typedef GAS unsigned long long gu64;
#define RLX_AGENT __ATOMIC_RELAXED, __HIP_MEMORY_SCOPE_AGENT
#define LDS_WAIT() asm volatile("s_waitcnt lgkmcnt(0)" ::: "memory")
#define VM_WAIT() asm volatile("s_waitcnt vmcnt(0)" ::: "memory")
__device__ __forceinline__ unsigned long long rt() { return __builtin_amdgcn_s_memrealtime(); }
__device__ __forceinline__ unsigned f2bf(float f) { unsigned u = __builtin_bit_cast(unsigned, f); return (u + 0x7fffu + ((u >> 16) & 1u)) >> 16; }
__device__ __forceinline__ unsigned pk2(float lo, float hi) { return f2bf(lo) | (f2bf(hi) << 16); }

typedef float f32x2 __attribute__((ext_vector_type(2)));
#define XB_TMO      128
#define XB_XCNT(j)  (256  + 64 * (j))
#define XB_XSUB(j)  (1280 + 64 * (j))
#define XB_XGEN(j)  (2304 + 64 * (j))
#define XB_TOP      3328
#define XB_TOPGEN   3392
#define XCD_BAR_WORDS 3456
#define XB_SPIN_CAP (1u << 18)

__device__ __forceinline__ unsigned xb_ld(unsigned* p)              { return __hip_atomic_load(p, __ATOMIC_RELAXED, __HIP_MEMORY_SCOPE_AGENT); }
__device__ __forceinline__ unsigned xb_add(unsigned* p, unsigned v) { return __hip_atomic_fetch_add(p, v, __ATOMIC_RELAXED, __HIP_MEMORY_SCOPE_AGENT); }
__device__ __forceinline__ unsigned xb_xcc_id() { return (unsigned)__builtin_amdgcn_s_getreg((3 << 11) | 20) & 0xFu; }
#define XB_SPIN(cond, bar) do { unsigned _sp = 0; while (cond) { __builtin_amdgcn_s_sleep(1); \
    if ((++_sp & 255u) == 0u) { if (xb_ld(&(bar)[XB_TMO])) break; if (_sp > XB_SPIN_CAP) { atomicAdd(&(bar)[XB_TMO], 1u); break; } } } } while (0)

struct XcdBarrier {
    unsigned* bar; unsigned x;
    volatile LAS unsigned* st;
};

__device__ __forceinline__ XcdBarrier xcd_barrier_post(unsigned* bar, volatile LAS unsigned* st) {
    XcdBarrier b; b.bar = bar; b.x = xb_xcc_id(); b.st = st;
    if (threadIdx.x == 0) (void)xb_add(&bar[XB_XCNT(b.x)], 1u);
    return b;
}
__device__ __forceinline__ void xcd_barrier_complete(unsigned* bar, unsigned x, unsigned& nloc, unsigned& nx) {
    const unsigned G = gridDim.x * gridDim.y * gridDim.z;
    unsigned sum, cnt, mine, sp = 0u;
    for (;;) {
        sum = 0u; cnt = 0u; mine = 0u;
#pragma unroll
        for (unsigned j = 0; j < 16; ++j) { const unsigned c = xb_ld(&bar[XB_XCNT(j)]); sum += c; cnt += (c > 0u) ? 1u : 0u; mine = (j == x) ? c : mine; }
        if (sum == G) break;
        __builtin_amdgcn_s_sleep(1);
        if ((++sp & 255u) == 0u) { if (xb_ld(&bar[XB_TMO])) break; if (sp > XB_SPIN_CAP) { atomicAdd(&bar[XB_TMO], 1u); break; } }
    }
    nloc = mine > 0u ? mine : 1u; nx = cnt > 0u ? cnt : 1u;
}

__device__ __forceinline__ void xcd_barrier(const XcdBarrier& b) {
    asm volatile("s_waitcnt vmcnt(0)" ::: "memory");
    __syncthreads();
    if (threadIdx.x == 0) {
        unsigned* bar = b.bar;
        __builtin_amdgcn_s_waitcnt(0);
        unsigned nloc = b.st[0], nx = b.st[1];
        if (nloc == 0u) { xcd_barrier_complete(bar, b.x, nloc, nx); b.st[0] = nloc; b.st[1] = nx; }
        const unsigned old = xb_add(&bar[XB_XSUB(b.x)], 1u);
        const unsigned gen = old / nloc;
        if (old + 1u == (gen + 1u) * nloc) {
            __builtin_amdgcn_fence(__ATOMIC_RELEASE, "agent");
            asm volatile("s_waitcnt vmcnt(0)" ::: "memory");
            const unsigned og = xb_add(&bar[XB_TOP], 1u);
            const unsigned tg = og / nx;
            if (og + 1u == (tg + 1u) * nx) xb_add(&bar[XB_TOPGEN], 1u);
            else XB_SPIN(xb_ld(&bar[XB_TOPGEN]) == tg, bar);
            __builtin_amdgcn_fence(__ATOMIC_ACQUIRE, "agent");
            xb_add(&bar[XB_XGEN(b.x)], 1u);
            asm volatile("s_waitcnt vmcnt(0)" ::: "memory");
        } else {
            XB_SPIN(xb_ld(&bar[XB_XGEN(b.x)]) == gen, bar);
            __builtin_amdgcn_fence(__ATOMIC_ACQUIRE, "agent");
            asm volatile("s_waitcnt vmcnt(0)" ::: "memory");
        }
    }
    __syncthreads();
}
constexpr int NWAVES = 8;
#ifndef MK_N_LAUNCHES
#define MK_N_LAUNCHES 1
#endif
constexpr int NPH = 18;
#ifndef ONLY_PH
#define ONLY_PH -1
#endif
#define PH_ON(n) (ONLY_PH < 0 || ONLY_PH == (n))
#ifndef REPEAT_MASK
#define REPEAT_MASK 0
#endif
static_assert(MK_N_LAUNCHES == 1 || MK_N_LAUNCHES == NPH, "MK_N_LAUNCHES is 1 or 18");

constexpr int BATCH = 8, SEQ = 4096, DM = 1024, M = BATCH * SEQ, DFF = 2816;
constexpr float ALPHA = 1.4142135623730951f;
constexpr float LN_EPS = 1e-5f, RMS_EPS = 1e-6f;
constexpr float LAMBDA_INIT = 0.35550906759096934f;
constexpr float C2_MLA = 0.07216878364870322f * 1.4426950408889634f;
constexpr float C2_DIFF = 0.125f * 1.4426950408889634f;
__device__ const float ROPE_INV[32] = {1.000000000e+00f, 7.498942018e-01f, 5.623413324e-01f, 4.216965139e-01f, 3.162277639e-01f, 2.371373922e-01f, 1.778279394e-01f, 1.333521456e-01f,
    1.000000015e-01f, 7.498941571e-02f, 5.623412877e-02f, 4.216964915e-02f, 3.162277862e-02f, 2.371373586e-02f, 1.778279431e-02f, 1.333521493e-02f,
    9.999999776e-03f, 7.498942316e-03f, 5.623413250e-03f, 4.216964822e-03f, 3.162277862e-03f, 2.371373819e-03f, 1.778279431e-03f, 1.333521446e-03f,
    1.000000047e-03f, 7.498941850e-04f, 5.623413017e-04f, 4.216965463e-04f, 3.162277862e-04f, 2.371373848e-04f, 1.778279402e-04f, 1.333521504e-04f};

constexpr size_t MiB = 1u << 20;
constexpr size_t WS_CTL = 0, CTL_ZERO_BYTES = 1 * MiB;
constexpr size_t WS_COS = 1 * MiB, WS_SIN = 1 * MiB + 512 * 1024;
constexpr size_t WS_W = 2 * MiB;
constexpr size_t WO_1 = 0, WO_2 = 786432, WO_3 = 1376256, WO_4 = 1900544, WO_5A = 2949120, WO_6A = 8716288, WO_7 = 11599872, WO_8 = 14745600, WO_5B = 15794176, WO_6B = 21561344, WO_END = 24444928;
static_assert(WS_W + WO_END * 2 <= 64 * MiB, "weights");
constexpr size_t WS_STATS = 56 * MiB;
constexpr size_t WS_HB = 64 * MiB;
constexpr size_t WS_G1OUT = 128 * MiB;
constexpr size_t WS_CQN = 224 * MiB, WS_CN = 248 * MiB;
constexpr size_t WS_KFULL = 264 * MiB;
constexpr size_t WS_VB = 360 * MiB;
constexpr size_t WS_QB = 128 * MiB;
constexpr size_t WS_OB = 424 * MiB;
constexpr size_t WS_ACT = 128 * MiB;
constexpr size_t WS_KVQ = 128 * MiB;
constexpr size_t WS_O2 = 320 * MiB;
constexpr size_t WS_OD = 448 * MiB;
constexpr size_t WS_END = 512 * MiB;
constexpr int CW_BAR = 4096;

constexpr int RING_OFF = 0, RING_BYTES = 131072;
constexpr int LDSCTL_OFF = RING_BYTES, MISC_OFF = LDSCTL_OFF + 320;
constexpr int LDS_BYTES = 147456;
static_assert(att::lds_bytes<192>() <= RING_BYTES && pg8::STAGE_BYTES <= RING_BYTES, "LDS");

struct Args { const float* in[22]; float* out; unsigned char* ws; int ph_lo, ph_hi, li, pad; };

__device__ __forceinline__ float wave_sum(float v) {
#pragma unroll
    for (int o = 1; o < 64; o <<= 1) v += __shfl_xor(v, o);
    return v;
}
__device__ __forceinline__ float bf2f(unsigned short b) { return __uint_as_float((unsigned)b << 16); }

__device__ __forceinline__ void sincos_acc(float ang, float& c, float& s) {
    const double a = (double)ang, k = __builtin_rint(a * 0.15915494309189535), r = a - k * 6.283185307179586, r2 = r * r;
    double tc = 1.0, sc = 1.0, ts = 1.0, ss = 1.0;
#pragma unroll
    for (int n = 1; n <= 14; ++n) { tc *= -r2 * (1.0 / (double)((2 * n - 1) * (2 * n))); sc += tc; ts *= -r2 * (1.0 / (double)((2 * n) * (2 * n + 1))); ss += ts; }
    c = (float)sc; s = (float)(r * ss);
}

__device__ __forceinline__ void transpose_item(const float* W, int K, int N, int csrc, bf16* WT, int nphys0, int k0, LAS float* scr, int lane) {
    if (W) {
#pragma unroll 8
        for (int i = 0; i < 32; ++i) { const int kk = 2 * i + (lane >> 5); scr[kk * 33 + (lane & 31)] = W[(size_t)(k0 + kk) * N + csrc + (lane & 31)]; }
    } else {
#pragma unroll 8
        for (int i = 0; i < 32; ++i) { const int kk = 2 * i + (lane >> 5); scr[kk * 33 + (lane & 31)] = 0.f; }
    }
    LDS_WAIT(); asm volatile("" ::: "memory");
    const int c = lane & 7;
#pragma unroll
    for (int j = 0; j < 4; ++j) { const int n = (lane >> 3) + 8 * j; const LAS float* s = scr + (8 * c) * 33 + n;
        v4u o; o.x = pk2(s[0 * 33], s[1 * 33]); o.y = pk2(s[2 * 33], s[3 * 33]); o.z = pk2(s[4 * 33], s[5 * 33]); o.w = pk2(s[6 * 33], s[7 * 33]);
        *(v4u*)(WT + (size_t)(nphys0 + n) * K + k0 + 8 * c) = o; }
    LDS_WAIT(); asm volatile("" ::: "memory");
}

__global__ void __launch_bounds__(NWAVES * 64, 2) mk_fwd(Args args) {
    extern __shared__ __attribute__((aligned(16))) unsigned char lds[];
    LAS unsigned char* ldsl = (LAS unsigned char*)lds;
    volatile LAS unsigned* MISC = (volatile LAS unsigned*)(ldsl + MISC_OFF);
    const int tid0 = threadIdx.x, wave = __builtin_amdgcn_readfirstlane(tid0 >> 6);
    const int G = gridDim.x; const int bx = blockIdx.x; const int vcu = (G % 8 == 0) ? (bx % 8) * (G / 8) + bx / 8 : bx;
    const int gw = vcu * NWAVES + wave, NGW = G * NWAVES;
    unsigned* ctl = (unsigned*)(args.ws + WS_CTL);
    for (int u = tid0; u < (LDS_BYTES - LDSCTL_OFF) / 4; u += NWAVES * 64) ((LAS unsigned*)(ldsl + LDSCTL_OFF))[u] = 0u;
    __syncthreads();
    XcdBarrier bar; bar.bar = ctl + CW_BAR; bar.x = 0; bar.st = nullptr;
    if (MK_N_LAUNCHES == 1) bar = xcd_barrier_post(ctl + CW_BAR, MISC + 8);
    cg::grid_group grid = cg::this_grid();

    for (int ph = args.ph_lo; ph < args.ph_hi; ++ph) {
      for (int rep = 0; rep < (((REPEAT_MASK >> ph) & 1) ? 2 : 1); ++rep) {
        int tid = wave * 64 + (int)__builtin_amdgcn_mbcnt_hi(~0u, __builtin_amdgcn_mbcnt_lo(~0u, 0u)); asm volatile("" : "+v"(tid)); const int lane = tid & 63;
        const __attribute__((address_space(4))) Args* ap = (const __attribute__((address_space(4))) Args*)__builtin_amdgcn_kernarg_segment_ptr(); asm volatile("" : "+s"(ap));
#define IN(k) ((const float*)(const GAS float*)ap->in[k])
        GAS unsigned char* ws = (GAS unsigned char*)ap->ws;
        float* cosT = (float*)(ws + WS_COS); float* sinT = (float*)(ws + WS_SIN);
        bf16* Wb = (bf16*)(ws + WS_W);
        bf16* HB = (bf16*)(ws + WS_HB); f32x2* STATS = (f32x2*)(ws + WS_STATS);
        float* G1OUT = (float*)(ws + WS_G1OUT);
        bf16* CQN = (bf16*)(ws + WS_CQN); bf16* CN = (bf16*)(ws + WS_CN);
        bf16* KFULL = (bf16*)(ws + WS_KFULL); bf16* VB = (bf16*)(ws + WS_VB); bf16* QB = (bf16*)(ws + WS_QB); bf16* OB = (bf16*)(ws + WS_OB);
        bf16* ACT = (bf16*)(ws + WS_ACT); bf16* KVQ = (bf16*)(ws + WS_KVQ); bf16* O2 = (bf16*)(ws + WS_O2); bf16* OD = (bf16*)(ws + WS_OD);
        float* T = (float*)(GAS float*)ap->out;
        switch (ph) {
        case 0: if (PH_ON(0)) {
            LAS float* scr = (LAS float*)(ldsl + RING_OFF + wave * 16384);
            constexpr int NMAT = 10;
            const int Kd[NMAT] = {1024, 384, 256, 1024, 1024, 2816, 1024, 1024, 1024, 2816};
            const int Np[NMAT] = {768, 1536, 2048, 1024, 5632, 1024, 3072, 1024, 5632, 1024};
            const size_t Wo[NMAT] = {WO_1, WO_2, WO_3, WO_4, WO_5A, WO_6A, WO_7, WO_8, WO_5B, WO_6B};
            constexpr int NITEMS = 11936;
            for (int it = gw; it < NITEMS; it += NGW) {
                int r = it, mat = 0;
#pragma unroll
                for (int q = 0; q < NMAT; ++q) { const int cnt = (Kd[q] / 64) * (Np[q] / 32); if (mat == q && r >= cnt) { r -= cnt; mat = q + 1; } }
                int K = 0, N = 0; size_t wo = 0;
#pragma unroll
                for (int q = 0; q < NMAT; ++q) if (mat == q) { K = Kd[q]; N = Np[q]; wo = Wo[q]; }
                const int nblk = N / 32, kb = r / nblk, pb = r % nblk;
                const int pn = pb >> 3, bj = (pb >> 2) & 1, g = pb & 3, paired = 256 * pn + 64 * g + 32 * bj;
                const float* src = nullptr; int sN = 0, col = 0;
                switch (mat) {
                case 0: if (pb < 12) { src = IN(1); sN = 384; col = 32 * pb; } else if (pb < 22) { src = IN(4); sN = 320; col = 32 * (pb - 12); } break;
                case 1: src = IN(3); sN = 1536; col = paired; break;
                case 2: src = IN(6); sN = 2048; col = paired; break;
                case 3: src = IN(7); sN = 1024; col = 32 * pb; break;
                case 4: src = IN(20); sN = 5632; col = bj ? (DFF + 128 * pn + 32 * g) : (128 * pn + 32 * g); break;
                case 8: src = IN(20) + (size_t)1024 * 5632; sN = 5632; col = bj ? (DFF + 128 * pn + 32 * g) : (128 * pn + 32 * g); break;
                case 5: src = IN(21); sN = 1024; col = 32 * pb; break;
                case 9: src = IN(21) + (size_t)DFF * 1024; sN = 1024; col = 32 * pb; break;
                case 6: if (paired < 2048) { src = IN(8); sN = 2048; col = paired; } else { src = IN(9); sN = 1024; col = paired - 2048; } break;
                default: src = IN(15); sN = 1024; col = 32 * pb; break;
                }
                transpose_item(src, K, sN, col, Wb + wo, 32 * pb, 64 * kb, scr, lane);
            }
            {
                const f32x4* x4 = (const f32x4*)IN(0); v4u* o = (v4u*)HB;
                for (int i = bx * 512 + tid; i < M * DM / 8; i += G * 512) { const f32x4 a = x4[2 * i], b = x4[2 * i + 1];
                    v4u w; w.x = pk2(a[0], a[1]); w.y = pk2(a[2], a[3]); w.z = pk2(b[0], b[1]); w.w = pk2(b[2], b[3]); o[i] = w; }
            }
            for (int i = bx * 512 + tid; i < SEQ * 32; i += G * 512) { float c, s; sincos_acc((float)(i >> 5) * ROPE_INV[i & 31], c, s); cosT[i] = c; sinT[i] = s; }
        } break;
        case 1: case 5: case 8: case 13: case 16: if (PH_ON(1)) {
            pg8::Gemm g; pg8::EpiF32 E;
            if (ph == 1) { g = pg8::Gemm{HB, Wb + WO_1, M, 768, 1024}; E = pg8::EpiF32{G1OUT, nullptr, 768, 0.f, nullptr, nullptr, nullptr}; }
            else if (ph == 5) { g = pg8::Gemm{OB, Wb + WO_4, M, 1024, 1024}; E = pg8::EpiF32{T, IN(0), 1024, ALPHA, nullptr, nullptr, nullptr}; }
            else if (ph == 8) { g = pg8::Gemm{ACT, Wb + WO_6A, M, 1024, DFF}; E = pg8::EpiF32{T, T, 1024, ALPHA, STATS, IN(16), IN(17)}; }
            else if (ph == 13) { g = pg8::Gemm{OD, Wb + WO_8, M, 1024, 1024}; E = pg8::EpiF32{T, T, 1024, ALPHA, STATS, IN(18), IN(19)}; }
            else { g = pg8::Gemm{ACT, Wb + WO_6B, M, 1024, DFF}; E = pg8::EpiF32{T, T, 1024, ALPHA, STATS, IN(16) + DM, IN(17) + DM}; }
            pg8::StaticOrder S; S.init(g.M, g.N, G, bx);
            pg8::gemm_phase<pg8::EpiF32, pg8::StaticOrder, true, true>(ldsl + RING_OFF, g, S, E, tid);
        } break;
        case 2: if (PH_ON(2)) {
            const float* qn = IN(2); const float* kn = IN(5);
            for (int row = gw; row < M; row += NGW) {
                const float* g1 = G1OUT + (size_t)row * 768;
                f32x2 c[3]; float ss = 0.f;
#pragma unroll
                for (int j = 0; j < 3; ++j) { c[j] = *(const f32x2*)(g1 + 2 * lane + 128 * j); ss += c[j].x * c[j].x + c[j].y * c[j].y; }
                f32x2 d[2]; float s2 = 0.f;
#pragma unroll
                for (int j = 0; j < 2; ++j) { d[j] = *(const f32x2*)(g1 + 384 + 2 * lane + 128 * j); s2 += d[j].x * d[j].x + d[j].y * d[j].y; }
                const float xr = g1[640 + lane];
                const float r1 = 1.f / sqrtf(wave_sum(ss) * (1.f / 384.f) + RMS_EPS), r2 = 1.f / sqrtf(wave_sum(s2) * (1.f / 256.f) + RMS_EPS);
#pragma unroll
                for (int j = 0; j < 3; ++j) { const f32x2 w = *(const f32x2*)(qn + 2 * lane + 128 * j); *(unsigned*)(CQN + (size_t)row * 384 + 2 * lane + 128 * j) = pk2(c[j].x * r1 * w.x, c[j].y * r1 * w.y); }
#pragma unroll
                for (int j = 0; j < 2; ++j) { const f32x2 w = *(const f32x2*)(kn + 2 * lane + 128 * j); *(unsigned*)(CN + (size_t)row * 256 + 2 * lane + 128 * j) = pk2(d[j].x * r2 * w.x, d[j].y * r2 * w.y); }
                const float xp = __shfl_xor(xr, 32); const int pos = row & (SEQ - 1), dd = lane & 31;
                const float cs = cosT[pos * 32 + dd], sn = sinT[pos * 32 + dd];
                const float ov = lane < 32 ? xr * cs - xp * sn : xr * cs + xp * sn;
                const float on = __shfl_xor(ov, 1);
                if ((lane & 1) == 0) { const unsigned w = pk2(ov, on);
#pragma unroll
                    for (int h = 0; h < 8; ++h) *(unsigned*)(KFULL + (size_t)row * 1536 + h * 192 + 128 + lane) = w; }
            }
        } break;
        case 3: case 10: if (PH_ON(3)) {
            const int j0 = ph == 3 ? 0 : 2, j1 = ph == 3 ? 2 : 3;
            for (int j = j0; j < j1; ++j) {
                pg8::Gemm g; pg8::EpiPair E;
                if (j == 0) { g = pg8::Gemm{CQN, Wb + WO_2, M, 1536, 384}; E = pg8::EpiPair{0, QB, nullptr, cosT, sinT}; }
                else if (j == 1) { g = pg8::Gemm{CN, Wb + WO_3, M, 2048, 256}; E = pg8::EpiPair{1, KFULL, VB, cosT, sinT}; }
                else { g = pg8::Gemm{HB, Wb + WO_7, M, 3072, 1024}; E = pg8::EpiPair{2, KVQ, nullptr, cosT, sinT}; }
                pg8::StaticOrder S; S.init(g.M, g.N, G, bx);
                pg8::gemm_phase<pg8::EpiPair, pg8::StaticOrder, true, true>(ldsl + RING_OFF, g, S, E, tid);
            }
        } break;
        case 4: if (PH_ON(4)) {
            for (int L = vcu; L < 64 * 8; L += G) { const int bh = L >> 3, s = L & 7, b = bh >> 3, h = bh & 7;
                const bf16* Qp = QB + (size_t)b * SEQ * 1536 + h * 192; const bf16* Kp = KFULL + (size_t)b * SEQ * 1536 + h * 192;
                const bf16* Vp = VB + (size_t)b * SEQ * 1024 + h * 128; bf16* Op = OB + (size_t)b * SEQ * 1024 + h * 128;
                for (int pass = 0; pass < 2; ++pass) att::attn_unit<192, 0, 1>(Qp, 1536, Kp, 1536, Vp, 1024, Op, 1024, pass ? s : 15 - s, C2_MLA, (char*)lds + RING_OFF, tid); }
        } break;
        case 11: if (PH_ON(11)) {
            for (int L = vcu; L < 128 * 8; L += G) { const int bv = L >> 3, s = L & 7, b = bv >> 4, vh = bv & 15;
                const bf16* base = KVQ + (size_t)b * SEQ * 3072;
                bf16* Op = O2 + (size_t)(vh & 1) * M * 1024 + (size_t)b * SEQ * 1024 + (vh >> 1) * 128;
                for (int pass = 0; pass < 2; ++pass) att::attn_unit_s<64, 8, 2>(base + 2048 + vh * 64, 3072, base + vh * 64, 3072, base + 1024 + (vh >> 1) * 128, 3072, Op, 1024, pass ? s : 15 - s, C2_DIFF, (char*)lds + RING_OFF, tid); }
        } break;
        case 6: case 9: case 14: case 17: if (PH_ON(6)) {
            const int l = ph >= 14 ? 1 : 0; const bool first = (ph == 6 || ph == 14);
            const float* gam = (first ? IN(16) : IN(18)) + l * DM; const float* bet = (first ? IN(17) : IN(19)) + l * DM;
            f32x4 gv[4], bv[4];
#pragma unroll
            for (int j = 0; j < 4; ++j) { gv[j] = *(const f32x4*)(gam + 4 * lane + 256 * j); bv[j] = *(const f32x4*)(bet + 4 * lane + 256 * j); }
            for (int row = gw; row < M; row += NGW) {
                float* tr = T + (size_t)row * DM + 4 * lane;
                f32x4 v[4]; float s = 0.f;
#pragma unroll
                for (int j = 0; j < 4; ++j) { v[j] = *(const f32x4*)(tr + 256 * j); s += (v[j].x + v[j].y) + (v[j].z + v[j].w); }
                const float mean = wave_sum(s) * (1.f / DM); float s2 = 0.f;
#pragma unroll
                for (int j = 0; j < 4; ++j) { v[j] = v[j] - mean; s2 += (v[j].x * v[j].x + v[j].y * v[j].y) + (v[j].z * v[j].z + v[j].w * v[j].w); }
                const float rstd = 1.f / sqrtf(wave_sum(s2) * (1.f / DM) + LN_EPS);
                if (ph != 17 && lane == 0) STATS[row] = (f32x2){mean, rstd};
#pragma unroll
                for (int j = 0; j < 4; ++j) { const f32x4 y = v[j] * rstd * gv[j] + bv[j]; if (ph == 17) *(f32x4*)(tr + 256 * j) = y;
                    if (ph != 17) { unsigned long long w = (unsigned long long)pk2(y.x, y.y) | ((unsigned long long)pk2(y.z, y.w) << 32); *(unsigned long long*)(HB + (size_t)row * DM + 4 * lane + 256 * j) = w; } }
            }
        } break;
        case 12: if (PH_ON(12)) {
            const float s1 = wave_sum(IN(10)[lane] * IN(11)[lane]), s2 = wave_sum(IN(12)[lane] * IN(13)[lane]);
            const float lam = expf(s1) - expf(s2) + LAMBDA_INIT;
            const int cc = (lane & 7) * 16; float sw[16];
#pragma unroll
            for (int j = 0; j < 16; ++j) sw[j] = IN(14)[cc + j] * (1.0f - LAMBDA_INIT);
            for (int row = gw; row < M; row += NGW) {
                const size_t off = (size_t)row * 1024 + (lane >> 3) * 128 + cc;
                const bf16x8 a0 = *(const bf16x8*)(O2 + off), a1 = *(const bf16x8*)(O2 + off + 8), b0 = *(const bf16x8*)(O2 + (size_t)M * 1024 + off), b1 = *(const bf16x8*)(O2 + (size_t)M * 1024 + off + 8);
                float o[16]; float ss = 0.f;
#pragma unroll
                for (int j = 0; j < 8; ++j) { o[j] = bf2f((unsigned short)a0[j]) - lam * bf2f((unsigned short)b0[j]); o[8 + j] = bf2f((unsigned short)a1[j]) - lam * bf2f((unsigned short)b1[j]); }
#pragma unroll
                for (int j = 0; j < 16; ++j) ss += o[j] * o[j];
                ss += __shfl_xor(ss, 1); ss += __shfl_xor(ss, 2); ss += __shfl_xor(ss, 4);
                const float rstd = 1.f / sqrtf(ss * (1.f / 128.f) + RMS_EPS);
                v4u w0, w1;
                w0.x = pk2(o[0] * rstd * sw[0], o[1] * rstd * sw[1]); w0.y = pk2(o[2] * rstd * sw[2], o[3] * rstd * sw[3]); w0.z = pk2(o[4] * rstd * sw[4], o[5] * rstd * sw[5]); w0.w = pk2(o[6] * rstd * sw[6], o[7] * rstd * sw[7]);
                w1.x = pk2(o[8] * rstd * sw[8], o[9] * rstd * sw[9]); w1.y = pk2(o[10] * rstd * sw[10], o[11] * rstd * sw[11]); w1.z = pk2(o[12] * rstd * sw[12], o[13] * rstd * sw[13]); w1.w = pk2(o[14] * rstd * sw[14], o[15] * rstd * sw[15]);
                *(v4u*)(OD + off) = w0; *(v4u*)(OD + off + 8) = w1;
            }
        } break;
        case 7: case 15: if (PH_ON(7)) {
            pg8::Gemm g{HB, Wb + (ph == 7 ? WO_5A : WO_5B), M, 2 * DFF, 1024}; pg8::EpiSwiglu E{ACT, DFF};
            pg8::StaticOrder S; S.init(g.M, g.N, G, bx);
            pg8::gemm_phase<pg8::EpiSwiglu, pg8::StaticOrder, true, true>(ldsl + RING_OFF, g, S, E, tid);
        } break;
        default: break;
        }
      }
        if (MK_N_LAUNCHES == 1 && ph + 1 < args.ph_hi) { if (ph == 0) grid.sync(); else xcd_barrier(bar); }
    }
}

extern "C" void kernel_launch(void* const* d_in, const int* in_sizes, int n_in, void* d_out, int out_size, void* d_ws, size_t ws_size, hipStream_t stream) {
    static int grid = 0;
    if (grid == 0) {
        if (n_in != 22 || in_sizes[0] != M * DM || out_size != M * DM || ws_size < WS_END) { fprintf(stderr, "kernel_launch: unexpected shapes (n_in %d, in0 %d, out %d, ws %zu); nothing launched\n", n_in, n_in > 0 ? in_sizes[0] : -1, out_size, ws_size); grid = -1; return; }
        int dev = 0, cus = 0, per_cu = 0;
        if (hipGetDevice(&dev) != hipSuccess || hipDeviceGetAttribute(&cus, hipDeviceAttributeMultiprocessorCount, dev) != hipSuccess) { fprintf(stderr, "kernel_launch: device query failed\n"); grid = -1; return; }
        if (hipFuncSetAttribute((const void*)mk_fwd, hipFuncAttributeMaxDynamicSharedMemorySize, LDS_BYTES) != hipSuccess) { fprintf(stderr, "kernel_launch: hipFuncSetAttribute failed\n"); grid = -1; return; }
        if (hipOccupancyMaxActiveBlocksPerMultiprocessor(&per_cu, (const void*)mk_fwd, NWAVES * 64, LDS_BYTES) != hipSuccess || per_cu < 1) { fprintf(stderr, "kernel_launch: occupancy query says %d\n", per_cu); per_cu = 1; }
        (void)hipGetLastError();
        grid = cus * 1;
    }
    if (grid < 0) return;
    if (hipMemsetAsync((char*)d_ws + WS_CTL, 0, CTL_ZERO_BYTES, stream) != hipSuccess) { fprintf(stderr, "kernel_launch: memset failed\n"); return; }
    Args a{};
    for (int i = 0; i < 22; ++i) a.in[i] = (const float*)d_in[i];
    a.out = (float*)d_out; a.ws = (unsigned char*)d_ws;
#if MK_N_LAUNCHES == 1
    a.ph_lo = 0; a.ph_hi = NPH; a.li = 0;
    void* kargs[] = {&a};
    const hipError_t e = hipLaunchCooperativeKernel((const void*)mk_fwd, dim3(grid), dim3(NWAVES * 64), kargs, LDS_BYTES, stream);
    if (e != hipSuccess) fprintf(stderr, "kernel_launch: cooperative launch failed: %s (grid %d)\n", hipGetErrorString(e), grid);
#else
    for (int ph = 0; ph < NPH; ++ph) { a.ph_lo = ph; a.ph_hi = ph + 1; a.li = ph; hipLaunchKernelGGL(mk_fwd, dim3(grid), dim3(NWAVES * 64), LDS_BYTES, stream, a); }
#endif
}
```
